# Optimizing an MI355X kernel written in HIP

```python
import jax, jax.numpy as jnp
from jax import lax
import numpy as np

D_MODEL = 2048
BATCH = 8
SEQ = 2048
DEPTH = 1

CHUNK = 64
Q_BLOCK = 128
N_MEM = 256
EPS = 1e-6

MLA_HEADS = 8
MLA_NOPE = 128
MLA_ROPE = 64
MLA_QK = MLA_NOPE + MLA_ROPE
MLA_V = 128
MLA_Q_RANK = 512
MLA_KV_RANK = 256
ROPE_THETA = 10000.0

GLA_HEADS = 4
GLA_DK = 128
GLA_DV = 256
GLA_GATE_RANK = 16
GLA_TAU = 16.0

MIX_WIDTH = MLA_HEADS * MLA_V + GLA_HEADS * GLA_DV

MEM_HEADS = 4
MEM_HEAD_DIM = 128
MEM_WIDTH = MEM_HEADS * MEM_HEAD_DIM

D_FF = 5632

IN_SIZES = [
    MLA_Q_RANK,
    MLA_KV_RANK,
    MLA_ROPE,
    GLA_HEADS * GLA_DK,
    GLA_HEADS * GLA_DK,
    GLA_HEADS * GLA_DV,
    GLA_GATE_RANK,
    GLA_HEADS * GLA_DV,
]
IN_WIDTH = int(sum(IN_SIZES))
IN_SPLITS = [int(s) for s in np.cumsum(IN_SIZES)[:-1]]

kernel_name = "hybrid_mla_gla_macaron_memory_block"


def rmsnorm(x, g):
    xf = x.astype(jnp.float32)
    y = xf * lax.rsqrt(jnp.mean(xf * xf, axis=-1, keepdims=True) + EPS)
    return (y * g.astype(jnp.float32)).astype(x.dtype)


def swiglu(h, w_gate, w_up, w_down):
    return (jax.nn.silu(h @ w_gate) * (h @ w_up)) @ w_down


def rope(x, positions):
    half = x.shape[-1] // 2
    inv_freq = ROPE_THETA ** (-jnp.arange(half, dtype=jnp.float32) / half)
    ang = positions.astype(jnp.float32)[..., None] * inv_freq
    cos = jnp.cos(ang)[:, :, None, :]
    sin = jnp.sin(ang)[:, :, None, :]
    xf = x.astype(jnp.float32)
    x1, x2 = xf[..., :half], xf[..., half:]
    return jnp.concatenate([x1 * cos - x2 * sin, x2 * cos + x1 * sin], axis=-1).astype(x.dtype)


def chunk_causal_attention(q, k, v):
    B, S, H, Dk = q.shape
    Dv = v.shape[-1]
    n_blk = S // Q_BLOCK
    scale = Dk ** -0.5
    k_chunk = jnp.arange(S) // CHUNK
    q_blocks = q.reshape(B, n_blk, Q_BLOCK, H, Dk).transpose(1, 0, 2, 3, 4)

    def one_block(args):
        q_blk, blk = args
        s = jnp.einsum('bqhd,bkhd->bhqk', q_blk, k).astype(jnp.float32) * scale
        q_chunk = (blk * Q_BLOCK + jnp.arange(Q_BLOCK)) // CHUNK
        mask = k_chunk[None, :] <= q_chunk[:, None]
        s = jnp.where(mask[None, None], s, -jnp.inf)
        p = jax.nn.softmax(s, axis=-1).astype(v.dtype)
        return jnp.einsum('bhqk,bkhd->bqhd', p, v)

    out = lax.map(one_block, (q_blocks, jnp.arange(n_blk)))
    return out.transpose(1, 0, 2, 3, 4).reshape(B, S, H, Dv)


def gla_chunked(q, k, v, log_a):
    B, S, H, K = q.shape
    V = v.shape[-1]
    n_chunk = S // CHUNK
    f32 = jnp.float32
    qc = q.astype(f32).reshape(B, n_chunk, CHUNK, H, K) * (K ** -0.5)
    kc = k.astype(f32).reshape(B, n_chunk, CHUNK, H, K)
    vc = v.astype(f32).reshape(B, n_chunk, CHUNK, H, V)
    g = log_a.astype(f32).reshape(B, n_chunk, CHUNK, H, K)
    b = jnp.cumsum(g, axis=2)
    b_end = b[:, :, -1]
    k_dec = kc * jnp.exp(b_end[:, :, None] - b)
    u = jnp.einsum('bnchk,bnchv->bnhkv', k_dec, vc)
    decay = jnp.exp(b_end)

    def step(state, inp):
        d, uc = inp
        state = d[..., None] * state + uc
        return state, state

    s0 = jnp.zeros((B, H, K, V), f32)
    _, states = lax.scan(step, s0, (decay.transpose(1, 0, 2, 3), u.transpose(1, 0, 2, 3, 4)))
    states = states.transpose(1, 0, 2, 3, 4)
    o = jnp.einsum('bnchk,bnhkv->bnchv', qc, states)
    return o.reshape(B, S, H, V).astype(v.dtype)


def memory_cross_attention(h, m, w_q, w_k, w_v, w_o, g_q, g_k):
    B, S, _ = h.shape
    M = m.shape[1]
    q = rmsnorm((h @ w_q).reshape(B, S, MEM_HEADS, MEM_HEAD_DIM), g_q)
    k = rmsnorm((m @ w_k).reshape(B, M, MEM_HEADS, MEM_HEAD_DIM), g_k)
    v = (m @ w_v).reshape(B, M, MEM_HEADS, MEM_HEAD_DIM)
    s = jnp.einsum('bqhd,bkhd->bhqk', q, k).astype(jnp.float32) * (MEM_HEAD_DIM ** -0.5)
    p = jax.nn.softmax(s, axis=-1).astype(v.dtype)
    o = jnp.einsum('bhqk,bkhd->bqhd', p, v).reshape(B, S, MEM_WIDTH)
    return o @ w_o


def setup_inputs(seed: int = 0) -> dict:
    key = jax.random.key(seed)
    keys = iter(jax.random.split(key, 40))
    f32 = jnp.float32

    def w(fan_in, fan_out):
        return jax.random.normal(next(keys), (DEPTH, fan_in, fan_out), f32) * fan_in ** -0.5

    def g(n):
        return 1.0 + 0.02 * jax.random.normal(next(keys), (DEPTH, n), f32)

    x = jax.random.normal(next(keys), (BATCH, SEQ, D_MODEL), f32)
    mem = jax.random.normal(next(keys), (BATCH, N_MEM, D_MODEL), f32)
    offset = jax.random.randint(next(keys), (BATCH, 1), 0, 64, dtype=jnp.int32) * CHUNK
    positions = (offset + jnp.arange(SEQ, dtype=jnp.int32)[None, :]).astype(jnp.int32)

    return {
        "x": x,
        "mem": mem,
        "positions": positions,
        "ffn1_norm": g(D_MODEL),
        "ffn1_w_gate": w(D_MODEL, D_FF),
        "ffn1_w_up": w(D_MODEL, D_FF),
        "ffn1_w_down": w(D_FF, D_MODEL),
        "mix_norm": g(D_MODEL),
        "w_in": w(D_MODEL, IN_WIDTH),
        "q_a_norm": g(MLA_Q_RANK),
        "w_q_up": w(MLA_Q_RANK, MLA_HEADS * MLA_QK),
        "kv_a_norm": g(MLA_KV_RANK),
        "w_kv_up": w(MLA_KV_RANK, MLA_HEADS * (MLA_NOPE + MLA_V)),
        "mla_q_norm": g(MLA_QK),
        "mla_k_norm": g(MLA_QK),
        "gla_w_gate2": w(GLA_GATE_RANK, GLA_HEADS * GLA_DK),
        "gla_b_gate": 0.1 * jax.random.normal(next(keys), (DEPTH, GLA_HEADS * GLA_DK), f32),
        "gla_out_norm": g(GLA_DV),
        "w_out": w(MIX_WIDTH, D_MODEL),
        "mem_attn_norm": g(D_MODEL),
        "mem_norm": g(D_MODEL),
        "mem_w_q": w(D_MODEL, MEM_WIDTH),
        "mem_w_k": w(D_MODEL, MEM_WIDTH),
        "mem_w_v": w(D_MODEL, MEM_WIDTH),
        "mem_w_o": w(MEM_WIDTH, D_MODEL),
        "mem_q_norm": g(MEM_HEAD_DIM),
        "mem_k_norm": g(MEM_HEAD_DIM),
        "ffn2_norm": g(D_MODEL),
        "ffn2_w_gate": w(D_MODEL, D_FF),
        "ffn2_w_up": w(D_MODEL, D_FF),
        "ffn2_w_down": w(D_FF, D_MODEL),
    }


def reference(x, mem, positions, ffn1_norm, ffn1_w_gate, ffn1_w_up, ffn1_w_down,
              mix_norm, w_in, q_a_norm, w_q_up, kv_a_norm, w_kv_up, mla_q_norm,
              mla_k_norm, gla_w_gate2, gla_b_gate, gla_out_norm, w_out,
              mem_attn_norm, mem_norm, mem_w_q, mem_w_k, mem_w_v, mem_w_o,
              mem_q_norm, mem_k_norm, ffn2_norm, ffn2_w_gate, ffn2_w_up, ffn2_w_down):
    B, S, _ = x.shape
    for l in range(DEPTH):
        x = x + 0.5 * swiglu(rmsnorm(x, ffn1_norm[l]), ffn1_w_gate[l], ffn1_w_up[l], ffn1_w_down[l])

        h = rmsnorm(x, mix_norm[l])
        z = h @ w_in[l]
        zq, zkv, zkr, gq, gk, gv, zg, zr = jnp.split(z, IN_SPLITS, axis=-1)

        q = (rmsnorm(zq, q_a_norm[l]) @ w_q_up[l]).reshape(B, S, MLA_HEADS, MLA_QK)
        kv = (rmsnorm(zkv, kv_a_norm[l]) @ w_kv_up[l]).reshape(B, S, MLA_HEADS, MLA_NOPE + MLA_V)
        k_nope, v = kv[..., :MLA_NOPE], kv[..., MLA_NOPE:]
        k_rope = jnp.broadcast_to(zkr[:, :, None, :], (B, S, MLA_HEADS, MLA_ROPE))
        k = jnp.concatenate([k_nope, k_rope], axis=-1)
        q = rmsnorm(q, mla_q_norm[l])
        k = rmsnorm(k, mla_k_norm[l])
        q = jnp.concatenate([q[..., :MLA_NOPE], rope(q[..., MLA_NOPE:], positions)], axis=-1)
        k = jnp.concatenate([k[..., :MLA_NOPE], rope(k[..., MLA_NOPE:], positions)], axis=-1)
        o_mla = chunk_causal_attention(q, k, v).reshape(B, S, MLA_HEADS * MLA_V)

        log_a = jax.nn.log_sigmoid((zg @ gla_w_gate2[l] + gla_b_gate[l]).astype(jnp.float32)) / GLA_TAU
        o_gla = gla_chunked(gq.reshape(B, S, GLA_HEADS, GLA_DK),
                            gk.reshape(B, S, GLA_HEADS, GLA_DK),
                            gv.reshape(B, S, GLA_HEADS, GLA_DV),
                            log_a.reshape(B, S, GLA_HEADS, GLA_DK))
        o_gla = rmsnorm(o_gla, gla_out_norm[l]).reshape(B, S, GLA_HEADS * GLA_DV) * jax.nn.silu(zr)

        x = x + jnp.concatenate([o_mla, o_gla], axis=-1) @ w_out[l]

        x = x + memory_cross_attention(rmsnorm(x, mem_attn_norm[l]), rmsnorm(mem, mem_norm[l]),
                                       mem_w_q[l], mem_w_k[l], mem_w_v[l], mem_w_o[l],
                                       mem_q_norm[l], mem_k_norm[l])

        x = x + 0.5 * swiglu(rmsnorm(x, ffn2_norm[l]), ffn2_w_gate[l], ffn2_w_up[l], ffn2_w_down[l])
    return x
```

```cpp
#include <hip/hip_runtime.h>
#include <hip/hip_cooperative_groups.h>
#include <cstdio>
#include <cstdint>
namespace cg = cooperative_groups;

#ifndef RMASK
#define RMASK 0
#endif
#ifndef MK_N_LAUNCHES
#define MK_N_LAUNCHES 1
#endif

#define LAS __attribute__((address_space(3)))
typedef unsigned short bf16_t;
typedef short bf16x8 __attribute__((ext_vector_type(8)));
typedef short s16x4 __attribute__((ext_vector_type(4)));
typedef float f32x4 __attribute__((ext_vector_type(4)));
typedef unsigned u32x4 __attribute__((ext_vector_type(4)));
typedef unsigned u32x2 __attribute__((ext_vector_type(2)));

constexpr int NB = 8, SEQ = 2048, T = NB * SEQ, D = 2048, FF = 5632;
constexpr int ZLD = 3072;
constexpr int ZQ = 0, ZKV = 512, ZKR = 768, ZGQ = 832, ZGK = 1344, ZZG = 1856, ZZR = 1872, ZUSED = 2896;
constexpr float EPS = 1e-6f;
constexpr float LOG2E = 1.4426950408889634f;

constexpr size_t MiB = 1u << 20;
constexpr size_t WS_WGU = 0, WS_WD = 44 * MiB;
constexpr size_t WS_WIN = 66 * MiB, WS_WOUT = 82 * MiB, WS_WMKV = 90 * MiB, WS_WMQ = 94 * MiB, WS_WMO = 96 * MiB, WS_WQUP = 98 * MiB, WS_WKVUP = 100 * MiB;
constexpr size_t WS_H = 104 * MiB;
constexpr size_t WS_ACT = 168 * MiB;
constexpr size_t WS_Z = 168 * MiB, WS_GVT = 264 * MiB, WS_QA = 296 * MiB, WS_KVA = 312 * MiB, WS_KDT = 320 * MiB, WS_DEC = 336 * MiB, WS_MK = 337 * MiB, WS_MVT = 339 * MiB;
constexpr size_t WS_Q = 344 * MiB, WS_K = 392 * MiB, WS_VT = 440 * MiB, WS_MEMN = 472 * MiB, WS_END = 480 * MiB;
constexpr size_t WS_MQ = WS_VT, WS_OMEM = WS_VT + 16 * MiB;
constexpr size_t WS_XB2 = WS_Q;
constexpr size_t WS_BAR = 103 * MiB;
constexpr size_t WS_SS = 101 * MiB;
constexpr size_t WS_OG = 480 * MiB, WS_END2 = 512 * MiB;

constexpr int LDS_BYTES = 131072 + 2048;

typedef __bf16 bf16x2_t __attribute__((ext_vector_type(2)));
typedef float f32x2_t __attribute__((ext_vector_type(2)));
__device__ __forceinline__ unsigned pk2(float lo, float hi) { f32x2_t v = {lo, hi}; bf16x2_t b = __builtin_convertvector(v, bf16x2_t); return __builtin_bit_cast(unsigned, b); }
__device__ __forceinline__ bf16_t f2bf(float f) { return (bf16_t)(pk2(f, 0.f) & 0xffffu); }
__device__ __forceinline__ float bf2f(bf16_t u) { return __builtin_bit_cast(float, (unsigned)u << 16); }
__device__ __forceinline__ float bflo(unsigned u) { return __builtin_bit_cast(float, u << 16); }
__device__ __forceinline__ float bfhi(unsigned u) { return __builtin_bit_cast(float, u & 0xffff0000u); }
template <int CTRL> __device__ __forceinline__ float dpp_mov(float v) {
    return __builtin_bit_cast(float, __builtin_amdgcn_update_dpp(0, __builtin_bit_cast(int, v), CTRL, 0xF, 0xF, true));
}
__device__ __forceinline__ float wave_sum(float v) {
    v += dpp_mov<0xB1>(v);
    v += dpp_mov<0x4E>(v);
    v += dpp_mov<0x141>(v);
    v += dpp_mov<0x140>(v);
    const int iv = __builtin_bit_cast(int, v);
    const float r0 = __builtin_bit_cast(float, __builtin_amdgcn_readlane(iv, 0)), r1 = __builtin_bit_cast(float, __builtin_amdgcn_readlane(iv, 16));
    const float r2 = __builtin_bit_cast(float, __builtin_amdgcn_readlane(iv, 32)), r3 = __builtin_bit_cast(float, __builtin_amdgcn_readlane(iv, 48));
    return (r0 + r1) + (r2 + r3);
}
__device__ __forceinline__ void swap16(float& a, float& b) { asm("s_nop 1\n\tv_permlane16_swap_b32 %0, %1" : "+v"(a), "+v"(b)); }
__device__ __forceinline__ void swap32(float& a, float& b) { asm("s_nop 1\n\tv_permlane32_swap_b32 %0, %1" : "+v"(a), "+v"(b)); }
__device__ __forceinline__ float xor16_sum(float v) { float a = v, b = v; swap16(a, b); return a + b; }
__device__ __forceinline__ float xor32_sum(float v) { float a = v, b = v; swap32(a, b); return a + b; }
__device__ __forceinline__ float xor16_max(float v) { float a = v, b = v; swap16(a, b); return fmaxf(a, b); }
__device__ __forceinline__ float xor32_max(float v) { float a = v, b = v; swap32(a, b); return fmaxf(a, b); }
__device__ __forceinline__ float lane_xor32(float v, int lane) { float a = v, b = v; swap32(a, b); return lane < 32 ? b : a; }
__device__ __forceinline__ float fast_silu(float g) { return g * __builtin_amdgcn_rcpf(1.f + __expf(-g)); }

namespace pg8 {
constexpr int BM = 256, BK = 64, HALF = 128, HTB = HALF * BK * 2, STAGE_BYTES = 8 * HTB, NXCD = 8, WGM = 8;
__host__ __device__ __forceinline__ int lds_byte(int r, int c) { const int st = (r >> 4) * 2 + (c >> 5), rr = r & 15, cc = c & 31, ob = rr * 64 + cc * 2; return st * 1024 + (ob ^ (((ob >> 9) & 1) << 5)); }
__host__ __device__ __forceinline__ void stage_rc(int b, int& R, int& C) { const int st = b / 1024, sb = b % 1024, swz = sb ^ (((sb >> 9) & 1) << 5); R = (st >> 1) * 16 + swz / 64; C = (st & 1) * 32 + (swz % 64) / 2; }
__host__ __device__ __forceinline__ int perm32(int rho) { const int n = rho >> 4, i = rho & 15; return 8 * (i >> 2) + 4 * n + (i & 3); }

struct Unit { int pm, pn; };
struct Gemm { const bf16_t* A; const bf16_t* Bt; int lda, ldb, K; };

struct StaticOrder {
    int nM, nN, nwg, G, c;
    __device__ void init(int M, int N, int G_, int c_) { nM = M / BM; nN = N / BM; nwg = nM * nN; G = G_; c = c_; }
    __device__ bool next(int i, Unit& u) const {
        const long L = (long)i * G + c; if (L >= nwg) return false;
        int wgid = (int)L; { const int q = nwg / NXCD, r = nwg % NXCD, xcd = wgid % NXCD, off = wgid / NXCD; wgid = (xcd < r ? xcd * (q + 1) : r * (q + 1) + (xcd - r) * q) + off; }
        const int nig = WGM * nN, gid = wgid / nig, fm = gid * WGM, gsz = (nM - fm) < WGM ? (nM - fm) : WGM;
        u.pm = fm + ((wgid % nig) % gsz); u.pn = (wgid % nig) / gsz; return true;
    }
};

struct EpiStore {
    bf16_t* O; int ldc; int remap; const float* ss; int smode;
    __device__ __forceinline__ void operator()(const f32x4 (&acc)[2][2][4][2], const Unit& u, int wr, int wc, int fr, int fq) const {
        const int row0 = u.pm * BM + wr * 64 + fr;
#pragma unroll
        for (int bj = 0; bj < 2; ++bj) {
            const int c = u.pn * BM + bj * HALF + wc * 32 + 8 * fq; const int dc = remap ? (c >> 7) * 192 + (c & 127) : c;
            f32x4 cs0 = (f32x4){1.f, 1.f, 1.f, 1.f}, cs1 = cs0;
            if (smode == 2) { const f32x4 t0 = *(const f32x4*)(ss + c), t1 = *(const f32x4*)(ss + c + 4);
#pragma unroll
                for (int e = 0; e < 4; ++e) { cs0[e] = rsqrtf(t0[e] * (1.f / 2048.f) + EPS); cs1[e] = rsqrtf(t1[e] * (1.f / 2048.f) + EPS); } }
#pragma unroll
            for (int ai = 0; ai < 2; ++ai)
#pragma unroll
                for (int m = 0; m < 4; ++m) {
                    const int row = row0 + ai * HALF + m * 16;
                    const float rs = (smode == 1) ? rsqrtf(ss[row] * (1.f / 2048.f) + EPS) : 1.f;
                    const f32x4 v0 = acc[ai][bj][m][0] * cs0 * rs, v1 = acc[ai][bj][m][1] * cs1 * rs; u32x4 w;
                    w.x = pk2(v0[0], v0[1]); w.y = pk2(v0[2], v0[3]); w.z = pk2(v1[0], v1[1]); w.w = pk2(v1[2], v1[3]);
                    size_t off = (size_t)row * ldc + dc;
                    if (remap == 3) {
                        const int b_ = c >> 11, ch_ = (c >> 6) & 31, s_ = (c >> 5) & 1, fq_ = (c >> 3) & 3, h_ = row >> 8, vs_ = (row >> 5) & 7, n_ = (row >> 4) & 1, fr_ = row & 15;
                        off = ((((size_t)((b_ * 4 + h_) * 8 + vs_) * 32 + ch_) * 4 + n_ * 2 + s_) * 64 + fq_ * 16 + fr_) * 8; }
                    *(u32x4*)(O + off) = w;
                }
        }
    }
};
struct EpiSwiglu {
    bf16_t* O; int ldc; const float* ss;
    __device__ __forceinline__ void operator()(const f32x4 (&acc)[2][2][4][2], const Unit& u, int wr, int wc, int fr, int fq) const {
        const int row0 = u.pm * BM + wr * 64 + fr; const int dc = u.pn * HALF + wc * 32 + 8 * fq;
#pragma unroll
        for (int ai = 0; ai < 2; ++ai)
#pragma unroll
            for (int m = 0; m < 4; ++m) {
                const int row = row0 + ai * HALF + m * 16;
                const float rs = ss ? rsqrtf(ss[row] * (1.f / 2048.f) + EPS) : 1.f;
                const f32x4 g0 = acc[ai][0][m][0] * rs, g1 = acc[ai][0][m][1] * rs, u0 = acc[ai][1][m][0] * rs, u1 = acc[ai][1][m][1] * rs; u32x4 w;
                w.x = pk2(fast_silu(g0[0]) * u0[0], fast_silu(g0[1]) * u0[1]); w.y = pk2(fast_silu(g0[2]) * u0[2], fast_silu(g0[3]) * u0[3]);
                w.z = pk2(fast_silu(g1[0]) * u1[0], fast_silu(g1[1]) * u1[1]); w.w = pk2(fast_silu(g1[2]) * u1[2], fast_silu(g1[3]) * u1[3]);
                *(u32x4*)(O + (size_t)row * ldc + dc) = w;
            }
    }
};
template <int ALPHA2, bool NORM, size_t XBOFF, size_t SSOFF>
struct EpiResid {
    const float* base; float* out; unsigned char* ws;
    __device__ __forceinline__ void operator()(const f32x4 (&acc)[2][2][4][2], const Unit& u, int wr, int wc, int fr, int fq) const {
        const int row0 = u.pm * BM + wr * 64 + fr; constexpr int ldc = 2048; constexpr float alpha = 0.5f * ALPHA2;
        bf16_t* const xb = (bf16_t*)(ws + XBOFF); __attribute__((address_space(1))) float* const ss = (__attribute__((address_space(1))) float*)(ws + SSOFF);
#pragma unroll
        for (int ai = 0; ai < 2; ++ai)
#pragma unroll
            for (int m = 0; m < 4; ++m) {
                const int row = row0 + ai * HALF + m * 16; float sq = 0.f;
#pragma unroll
                for (int bj = 0; bj < 2; ++bj)
#pragma unroll
                    for (int n = 0; n < 2; ++n) {
                        const size_t idx = (size_t)row * ldc + u.pn * BM + bj * HALF + wc * 32 + 8 * fq + 4 * n;
                        const f32x4 b = *(const f32x4*)(base + idx);
                        const f32x4 v = b + acc[ai][bj][m][n] * alpha;
                        *(f32x4*)(out + idx) = v;
                        if (NORM) { u32x2 w; w.x = pk2(v[0], v[1]); w.y = pk2(v[2], v[3]); *(u32x2*)(xb + idx) = w; sq += (v[0] * v[0] + v[1] * v[1]) + (v[2] * v[2] + v[3] * v[3]); }
                    }
                if (NORM) { sq = xor16_sum(sq); sq = xor32_sum(sq); if (fq == 0) __hip_atomic_fetch_add(ss + row, sq, __ATOMIC_RELAXED, __HIP_MEMORY_SCOPE_AGENT); }
            }
    }
};

#ifndef PG8_ALIGN
#define PG8_ALIGN true
#endif
template <class Epi, bool ALIGN_EPI = PG8_ALIGN>
__device__ __forceinline__ void gemm_phase(LAS unsigned char* lds, const Gemm g, const StaticOrder S, const Epi E) {
    const int tid = threadIdx.x, wid = __builtin_amdgcn_readfirstlane(tid >> 6), lane = tid & 63, wr = wid >> 2, wc = wid & 3, fr = lane & 15, fq = lane >> 4;
    const int K = g.K, nt = K / BK;
    unsigned voffA[2], voffB[2];
#pragma unroll
    for (int i = 0; i < 2; ++i) { int R, C; stage_rc(tid * 16 + i * 8192, R, C); const int Rb = (R & ~31) + perm32(R & 31);
        voffA[i] = (unsigned)(R * g.lda + C) * 2u; voffB[i] = (unsigned)(Rb * g.ldb + C) * 2u; }
    const size_t kstep = (size_t)(BK * 2);
    const size_t hstepA = (size_t)HALF * g.lda * 2, hstepB = (size_t)HALF * g.ldb * 2;
    const size_t tstepA = 2 * hstepA, tstepB = 2 * hstepB;
    const unsigned ldsw = (unsigned)wid * 1024u;
    const int aoff = lds_byte(wr * 64 + fr, fq * 8), boff = lds_byte(wc * 32 + fr, fq * 8);
#define PG8_SA(b, h) (((b) * 2 + (h)) * HTB)
#define PG8_SB(b, h) ((4 + (b) * 2 + (h)) * HTB)
#define PG8_STAGE(bufoff, gbase, voff) do { _Pragma("unroll") for (int _i = 0; _i < 2; ++_i) \
        __builtin_amdgcn_global_load_lds((const unsigned*)((const char*)(gbase) + (voff)[_i]), (LAS unsigned*)(lds + (bufoff) + ldsw + _i * 8192), 16, 0, 0); } while (0)
#define PG8_LDA(dst, b, h) do { _Pragma("unroll") for (int m = 0; m < 4; ++m) _Pragma("unroll") for (int k = 0; k < 2; ++k) dst[m][k] = *(const LAS bf16x8*)(lds + PG8_SA(b, h) + aoff + m * 2048 + k * 1024); } while (0)
#define PG8_LDB(dst, b, h) do { _Pragma("unroll") for (int n = 0; n < 2; ++n) _Pragma("unroll") for (int k = 0; k < 2; ++k) dst[n][k] = *(const LAS bf16x8*)(lds + PG8_SB(b, h) + boff + n * 2048 + k * 1024); } while (0)
#define PG8_MMA(ai, bj, At, Bt) do { __builtin_amdgcn_s_setprio(1); _Pragma("unroll") for (int m = 0; m < 4; ++m) _Pragma("unroll") for (int n = 0; n < 2; ++n) _Pragma("unroll") for (int k = 0; k < 2; ++k) \
        acc[ai][bj][m][n] = __builtin_amdgcn_mfma_f32_16x16x32_bf16(Bt[n][k], At[m][k], acc[ai][bj][m][n], 0, 0, 0); __builtin_amdgcn_s_setprio(0); } while (0)
#define PG8_WAIT_V(n) asm volatile("s_waitcnt vmcnt(" #n ")" ::: "memory")
#define PG8_WAIT_L(n) asm volatile("s_waitcnt lgkmcnt(" #n ")" ::: "memory")
#define PG8_BAR __builtin_amdgcn_s_barrier()
#define PG8_SCHED __builtin_amdgcn_sched_barrier(0)
    Unit cur, nxt; int ui = 0;
    if (!S.next(0, cur)) return;
    f32x4 acc[2][2][4][2];
#pragma unroll
    for (int a = 0; a < 2; ++a)
#pragma unroll
        for (int b = 0; b < 2; ++b)
#pragma unroll
            for (int m = 0; m < 4; ++m)
#pragma unroll
                for (int n = 0; n < 2; ++n) acc[a][b][m][n] = (f32x4){0.f, 0.f, 0.f, 0.f};
    bf16x8 At[4][2], B0[2][2], B1[2][2];
    const char* cA = (const char*)g.A + (size_t)cur.pm * tstepA; const char* cB = (const char*)g.Bt + (size_t)cur.pn * tstepB;
    PG8_STAGE(PG8_SB(0, 0), cB, voffB); PG8_STAGE(PG8_SB(0, 1), cB + hstepB, voffB); PG8_STAGE(PG8_SA(0, 0), cA, voffA); PG8_STAGE(PG8_SA(0, 1), cA + hstepA, voffA);
    if (wr == 1) PG8_BAR;
    PG8_WAIT_V(2); PG8_BAR;
    PG8_STAGE(PG8_SB(1, 0), cB + kstep, voffB); PG8_STAGE(PG8_SA(1, 0), cA + kstep, voffA); PG8_STAGE(PG8_SB(1, 1), cB + hstepB + kstep, voffB);
    PG8_WAIT_V(6); PG8_BAR;
    for (;;) {
        const bool has_next = S.next(ui + 1, nxt);
        const char* nA = has_next ? (const char*)g.A + (size_t)nxt.pm * tstepA : cA; const char* nB = has_next ? (const char*)g.Bt + (size_t)nxt.pn * tstepB : cB;
        for (int t = 0; t < nt; t += 2) {
            const bool last = (t == nt - 2);
            const char* a1 = cA + (size_t)(t + 1) * kstep;
            const char* a2 = last ? nA : cA + (size_t)(t + 2) * kstep; const char* b2 = last ? nB : cB + (size_t)(t + 2) * kstep;
            const char* a3 = a2 + kstep; const char* b3 = b2 + kstep;
            PG8_LDB(B0, 0, 0); PG8_LDB(B1, 0, 1); PG8_SCHED; PG8_LDA(At, 0, 0); PG8_STAGE(PG8_SA(1, 1), a1 + hstepA, voffA);
            PG8_WAIT_V(8); PG8_WAIT_L(0); PG8_BAR; PG8_MMA(0, 0, At, B0); PG8_MMA(0, 1, At, B1); PG8_BAR; PG8_SCHED;
            PG8_LDA(At, 0, 1); PG8_STAGE(PG8_SB(0, 0), b2, voffB); PG8_STAGE(PG8_SB(0, 1), b2 + hstepB, voffB); PG8_STAGE(PG8_SA(0, 0), a2, voffA);
            PG8_WAIT_V(8); PG8_WAIT_L(0); PG8_BAR; PG8_MMA(1, 0, At, B0); PG8_MMA(1, 1, At, B1); PG8_BAR; PG8_SCHED;
            PG8_LDB(B0, 1, 0); PG8_LDB(B1, 1, 1); PG8_SCHED; PG8_LDA(At, 1, 0); PG8_STAGE(PG8_SA(0, 1), a2 + hstepA, voffA);
            PG8_WAIT_V(8); PG8_WAIT_L(0); PG8_BAR; PG8_MMA(0, 0, At, B0); PG8_MMA(0, 1, At, B1); PG8_BAR; PG8_SCHED;
            PG8_LDA(At, 1, 1); PG8_STAGE(PG8_SB(1, 0), b3, voffB); PG8_STAGE(PG8_SB(1, 1), b3 + hstepB, voffB); PG8_STAGE(PG8_SA(1, 0), a3, voffA);
            PG8_WAIT_V(8); PG8_WAIT_L(0); PG8_BAR; PG8_MMA(1, 0, At, B0); PG8_MMA(1, 1, At, B1); PG8_BAR; PG8_SCHED;
        }
        if (ALIGN_EPI) { if (wr == 0) PG8_BAR; }
        E(acc, cur, wr, wc, fr, fq);
        if (!has_next) break;
#pragma unroll
        for (int a = 0; a < 2; ++a)
#pragma unroll
            for (int b = 0; b < 2; ++b)
#pragma unroll
                for (int m = 0; m < 4; ++m)
#pragma unroll
                    for (int n = 0; n < 2; ++n) acc[a][b][m][n] = (f32x4){0.f, 0.f, 0.f, 0.f};
        cur = nxt; cA = nA; cB = nB; ++ui;
        if (ALIGN_EPI) { if (wr == 1) PG8_BAR; }
    }
    PG8_WAIT_V(0);
    if (!ALIGN_EPI) { if (wr == 0) PG8_BAR; }
    PG8_BAR;
#undef PG8_SA
#undef PG8_SB
#undef PG8_STAGE
#undef PG8_LDA
#undef PG8_LDB
#undef PG8_MMA
#undef PG8_WAIT_V
#undef PG8_WAIT_L
#undef PG8_BAR
#undef PG8_SCHED
}
}

struct Args {
    const float* in[31];
    float* out;
    unsigned char* ws;
    int ph_lo, ph_hi, rmask, pad;
};

__device__ __forceinline__ int cvt_row(int kind, int n) {
    switch (kind) {
        case 1: return (n >> 7) * 256 + (n & 127);
        case 2: return (n >> 7) * 256 + 128 + (n & 127);
        case 3: return n < 1856 ? n : (n < 2880 ? 3072 + (n - 1856) : n - 1024);
        case 4: { const int h = n >> 8, j = n & 255; return j < 128 ? h * 128 + j : 1024 + h * 128 + (j - 128); }
        case 5: return 512 + n;
        default: return n;
    }
}
struct CvtJob { const float* W; bf16_t* WT; const float* gam; int K, N, kind, item; bool ok; };
__device__ __forceinline__ int cvt_nitems(int K, int N) { return (K / 64) * ((N + 255) / 256); }
__device__ __forceinline__ void cvt_load(const CvtJob& J, f32x4 (&cv)[8], int wave, int lane) {
    const int nblk = (J.N + 255) / 256, kb = J.item / nblk, nb = J.item % nblk, k0 = 64 * kb, n0 = 256 * nb;
    const bool nok = (n0 + 4 * lane) < J.N;
#pragma unroll
    for (int i = 0; i < 8; ++i) { const int k = k0 + wave + 8 * i;
        cv[i] = nok ? *(const f32x4*)(J.W + (size_t)k * J.N + n0 + 4 * lane) : (f32x4){0.f, 0.f, 0.f, 0.f};
        if (J.gam) cv[i] = cv[i] * J.gam[k]; }
}
__device__ __forceinline__ void cvt_to_lds(const f32x4 (&cv)[8], LAS unsigned char* lds, int wave, int lane) {
#pragma unroll
    for (int i = 0; i < 8; ++i) { const int k = wave + 8 * i; *(LAS f32x4*)(lds + (size_t)k * 1024 + (((4 * lane) ^ (4 * (k >> 3))) * 4)) = cv[i]; }
}
__device__ __forceinline__ void cvt_from_lds(const CvtJob& J, LAS unsigned char* lds, int tid) {
    const int nblk = (J.N + 255) / 256, kb = J.item / nblk, nb = J.item % nblk, k0 = 64 * kb, n0 = 256 * nb;
#pragma unroll
    for (int j = 0; j < 4; ++j) {
        const int q = tid + 512 * j, n = q >> 3, c = q & 7;
        const LAS float* sp = (const LAS float*)lds + (8 * c) * 256 + (n ^ (4 * c));
        u32x4 o; o.x = pk2(sp[0 * 256], sp[1 * 256]); o.y = pk2(sp[2 * 256], sp[3 * 256]); o.z = pk2(sp[4 * 256], sp[5 * 256]); o.w = pk2(sp[6 * 256], sp[7 * 256]);
        if (n0 + n < J.N) *(u32x4*)(J.WT + (size_t)cvt_row(J.kind, n0 + n) * J.K + k0 + 8 * c) = o;
    }
}

__device__ __forceinline__ void rms_row2048(const float* xrow, const float* g, bf16_t* orow, int lane) {
    const f32x4* xr = (const f32x4*)xrow + lane; const f32x4* gr = (const f32x4*)g + lane;
    f32x4 v[8]; float s = 0.f;
#pragma unroll
    for (int j = 0; j < 8; ++j) { v[j] = xr[64 * j]; s += (v[j].x * v[j].x + v[j].y * v[j].y) + (v[j].z * v[j].z + v[j].w * v[j].w); }
    const float r = rsqrtf(wave_sum(s) * (1.f / 2048.f) + EPS);
    u32x2* o8 = (u32x2*)orow + lane;
#pragma unroll
    for (int j = 0; j < 8; ++j) { const f32x4 gg = gr[64 * j]; u32x2 w; w.x = pk2(v[j].x * r * gg.x, v[j].y * r * gg.y); w.y = pk2(v[j].z * r * gg.z, v[j].w * r * gg.w); o8[64 * j] = w; }
}

__device__ __forceinline__ void norm_rope192(bf16_t* p0, const bf16_t* p2, bf16_t* d2, const float* g, float cs, float sn, float oscale, int lane) {
    const float a0 = bf2f(p0[lane]), a1 = bf2f(p0[64 + lane]), a2 = bf2f(p2[lane]);
    const float ss = wave_sum(a0 * a0 + a1 * a1 + a2 * a2);
    const float r = rsqrtf(ss * (1.f / 192.f) + EPS);
    const float n0 = a0 * r * g[lane], n1 = a1 * r * g[64 + lane], n2 = a2 * r * g[128 + lane];
    const float pr = lane_xor32(n2, lane);
    const float ro = (lane < 32) ? (n2 * cs - pr * sn) : (n2 * cs + pr * sn);
    p0[lane] = f2bf(n0 * oscale); p0[64 + lane] = f2bf(n1 * oscale); d2[lane] = f2bf(ro * oscale);
}
__device__ __forceinline__ void norm128(bf16_t* p, const float* g, float oscale, int lane) {
    const unsigned u = ((const unsigned*)p)[lane]; const float a0 = bflo(u), a1 = bfhi(u);
    const float ss = wave_sum(a0 * a0 + a1 * a1);
    const float r = rsqrtf(ss * (1.f / 128.f) + EPS) * oscale;
    ((unsigned*)p)[lane] = pk2(a0 * r * g[2 * lane], a1 * r * g[2 * lane + 1]);
}
__device__ __forceinline__ float log_sigmoid(float x) { return fminf(x, 0.f) - __logf(1.f + __expf(-fabsf(x))); }

__device__ __forceinline__ void gla_prep_item(LAS unsigned char* lds, int item, const bf16_t* Z, const float* W2, const float* Bg, bf16_t* KDT, float* DEC) {
    LAS float* zgs = (LAS float*)lds;
    const int tid = threadIdx.x, b = item >> 5, c = item & 31; const size_t row0 = (size_t)b * SEQ + c * 64;
    for (int i = tid; i < 1024; i += 512) { const int t = i >> 4, r = i & 15; zgs[i] = bf2f(Z[(row0 + t) * ZLD + ZZG + r]); }
    __syncthreads();
    const int h = tid >> 7, kd = tid & 127, col = h * 128 + kd;
    float w[16];
#pragma unroll
    for (int r = 0; r < 16; ++r) w[r] = W2[r * 512 + col];
    const float bias = Bg[col];
    float bend = 0.f; float gv[64];
#pragma unroll
    for (int t = 0; t < 64; ++t) {
        float x = bias;
#pragma unroll
        for (int r = 0; r < 16; ++r) x += zgs[t * 16 + r] * w[r];
        gv[t] = log_sigmoid(x) * (1.f / 16.f); bend += gv[t];
    }
    float bc = 0.f;
    bf16_t* dst = KDT + (size_t)((b * 4 + h) * 32 + c) * 8192 + (size_t)((kd >> 4) * 2 * 64 + (kd & 15)) * 8;
    const bf16_t* gk = Z + row0 * ZLD + ZGK + col;
#pragma unroll
    for (int t8 = 0; t8 < 8; ++t8) {
        float kv[8];
#pragma unroll
        for (int e = 0; e < 8; ++e) {
            const int t = t8 * 8 + e;
            bc += gv[t];
            kv[e] = bf2f(gk[(size_t)t * ZLD]) * __expf(bend - bc);
        }
        u32x4 o; o.x = pk2(kv[0], kv[1]); o.y = pk2(kv[2], kv[3]); o.z = pk2(kv[4], kv[5]); o.w = pk2(kv[6], kv[7]);
        *(u32x4*)(dst + ((t8 >> 2) * 64 + (t8 & 3) * 16) * 8) = o;
    }
    DEC[(size_t)((b * 4 + h) * 32 + c) * 128 + kd] = expf(bend);
    __syncthreads();
}

struct GlaSet { bf16x8 a[2], bb[2][2], qa[4]; f32x4 d; };
__device__ __forceinline__ void gla_item(LAS unsigned char* lds, int item, const bf16_t* KDT, const float* DEC, const bf16_t* GVT, const bf16_t* GQF, bf16_t* OG) {
    const int tid = threadIdx.x, wid = __builtin_amdgcn_readfirstlane(tid >> 6), lane = tid & 63, fr = lane & 15, fq = lane >> 4;
    const int vs = item & 7, h = (item >> 3) & 3, b = item >> 5;
    const bf16_t* kdt = KDT + (size_t)((b * 4 + h) * 32) * 8192 + (size_t)(wid * 2 * 64 + lane) * 8;
    const float* dec = DEC + (size_t)((b * 4 + h) * 32) * 128 + 16 * wid + 4 * fq;
    const bf16_t* gvt = GVT + (size_t)item * (32 * 4 * 512) + (size_t)lane * 8;
    const int f0 = 16 * (wid & 3), v0 = 16 * (wid >> 2);
    const bf16_t* gq = GQF + ((size_t)((b * 4 + h) * 32) * 16 + (size_t)(wid & 3) * 4) * 512 + (size_t)lane * 8;
    bf16_t* outp = OG + (size_t)item * (SEQ * 32) + (size_t)(f0 + fr) * 32 + v0 + 4 * fq;
    f32x4 S[2]; S[0] = (f32x4){0.f, 0.f, 0.f, 0.f}; S[1] = S[0];
#define GLA_LOAD(X, c_) do { \
        _Pragma("unroll") for (int s = 0; s < 2; ++s) X.a[s] = *(const bf16x8*)(kdt + (size_t)(c_) * 8192 + s * 512); \
        _Pragma("unroll") for (int n = 0; n < 2; ++n) _Pragma("unroll") for (int s = 0; s < 2; ++s) X.bb[n][s] = *(const bf16x8*)(gvt + (size_t)(c_) * 2048 + (n * 2 + s) * 512); \
        _Pragma("unroll") for (int s = 0; s < 4; ++s) X.qa[s] = *(const bf16x8*)(gq + (size_t)(c_) * (16 * 512) + s * 512); \
        X.d = *(const f32x4*)(dec + (c_) * 128); } while (0)
#define GLA_STEP(X, c_) do { \
        LAS unsigned char* Sb = lds + ((c_) & 1) * (32 * 272); \
        _Pragma("unroll") for (int n = 0; n < 2; ++n) { \
            S[n] = S[n] * X.d; \
            _Pragma("unroll") for (int s = 0; s < 2; ++s) S[n] = __builtin_amdgcn_mfma_f32_16x16x32_bf16(X.a[s], X.bb[n][s], S[n], 0, 0, 0); \
            u32x2 w_; w_.x = pk2(S[n][0], S[n][1]); w_.y = pk2(S[n][2], S[n][3]); \
            *(LAS u32x2*)(Sb + (16 * n + fr) * 272 + (16 * wid + 4 * fq) * 2) = w_; } \
        __syncthreads(); \
        f32x4 o_ = (f32x4){0.f, 0.f, 0.f, 0.f}; \
        _Pragma("unroll") for (int s = 0; s < 4; ++s) { const bf16x8 bf_ = *(const LAS bf16x8*)(Sb + (v0 + fr) * 272 + s * 64 + fq * 16); o_ = __builtin_amdgcn_mfma_f32_16x16x32_bf16(bf_, X.qa[s], o_, 0, 0, 0); } \
        o_ = o_ * 0.08838834764831845f; \
        u32x2 ow_; ow_.x = pk2(o_[0], o_[1]); ow_.y = pk2(o_[2], o_[3]); *(u32x2*)(outp + (size_t)(c_) * 64 * 32) = ow_; } while (0)
    GlaSet s0, s1, s2;
    GLA_LOAD(s0, 0); GLA_LOAD(s1, 1);
#pragma unroll 1
    for (int c = 0; c < 30; c += 3) {
        GLA_LOAD(s2, c + 2); GLA_STEP(s0, c);
        GLA_LOAD(s0, c + 3); GLA_STEP(s1, c + 1);
        GLA_LOAD(s1, c + 4); GLA_STEP(s2, c + 2);
    }
    GLA_STEP(s0, 30); GLA_STEP(s1, 31);
#undef GLA_LOAD
#undef GLA_STEP
    __syncthreads();
}

template <int DQK, int QF>
__device__ __forceinline__ void attn_unit(LAS unsigned char* lds, const bf16_t* Qp, int ldq, const bf16_t* Kp, int ldk, const bf16_t* VTp, int ldvt, bf16_t* Op, int ldo, int nkt, int wave_last, const float* qgam, float qscale) {
    constexpr int KS = DQK / 32, KROW = DQK * 2 + 16, VROW = 144, KBYTES = 64 * KROW, VBYTES = 128 * VROW, BUF = KBYTES + VBYTES;
    constexpr int KCPR = DQK / 8, NKL = (64 * KCPR) / 512;
    const int tid = threadIdx.x, wid = __builtin_amdgcn_readfirstlane(tid >> 6), lane = tid & 63, fr = lane & 15, fq = lane >> 4;
    bf16x8 qreg[QF][KS];
#pragma unroll
    for (int qf = 0; qf < QF; ++qf)
#pragma unroll
        for (int s = 0; s < KS; ++s) qreg[qf][s] = *(const bf16x8*)(Qp + (size_t)(16 * QF * wid + 16 * qf + fr) * ldq + s * 32 + fq * 8);
    if (qgam) {
#pragma unroll
        for (int qf = 0; qf < QF; ++qf) {
            float sq = 0.f;
#pragma unroll
            for (int s = 0; s < KS; ++s)
#pragma unroll
                for (int e = 0; e < 8; ++e) { const float v = bf2f((bf16_t)qreg[qf][s][e]); sq += v * v; }
            sq = xor16_sum(sq); sq = xor32_sum(sq);
            const float r = rsqrtf(sq * (1.f / DQK) + EPS) * qscale;
#pragma unroll
            for (int s = 0; s < KS; ++s) {
                const f32x4 g0 = *(const f32x4*)(qgam + s * 32 + fq * 8), g1 = *(const f32x4*)(qgam + s * 32 + fq * 8 + 4); u32x4 w;
                w.x = pk2(bf2f((bf16_t)qreg[qf][s][0]) * r * g0[0], bf2f((bf16_t)qreg[qf][s][1]) * r * g0[1]); w.y = pk2(bf2f((bf16_t)qreg[qf][s][2]) * r * g0[2], bf2f((bf16_t)qreg[qf][s][3]) * r * g0[3]);
                w.z = pk2(bf2f((bf16_t)qreg[qf][s][4]) * r * g1[0], bf2f((bf16_t)qreg[qf][s][5]) * r * g1[1]); w.w = pk2(bf2f((bf16_t)qreg[qf][s][6]) * r * g1[2], bf2f((bf16_t)qreg[qf][s][7]) * r * g1[3]);
                qreg[qf][s] = __builtin_bit_cast(bf16x8, w);
            }
        }
    }
    f32x4 o[QF][8];
#pragma unroll
    for (int qf = 0; qf < QF; ++qf)
#pragma unroll
        for (int mv = 0; mv < 8; ++mv) o[qf][mv] = (f32x4){0.f, 0.f, 0.f, 0.f};
    float mrun[QF], lrun[QF];
#pragma unroll
    for (int qf = 0; qf < QF; ++qf) { mrun[qf] = -1e30f; lrun[qf] = 0.f; }
    u32x4 kst[NKL], vst[2];
    int kgo[NKL], klo[NKL], vgo[2], vlo[2];
#pragma unroll
    for (int i = 0; i < NKL; ++i) { const int q = tid + 512 * i, row = q / KCPR, cc = q % KCPR; kgo[i] = row * ldk + cc * 8; klo[i] = row * KROW + cc * 16; }
#pragma unroll
    for (int i = 0; i < 2; ++i) { const int q = tid + 512 * i, row = q >> 3, cc = q & 7; vgo[i] = row * ldvt + cc * 8; vlo[i] = KBYTES + row * VROW + cc * 16; }
#define AT_LOAD(t_) do { _Pragma("unroll") for (int i = 0; i < NKL; ++i) kst[i] = *(const u32x4*)(Kp + (size_t)(t_) * 64 * ldk + kgo[i]); \
        _Pragma("unroll") for (int i = 0; i < 2; ++i) vst[i] = *(const u32x4*)(VTp + (size_t)(t_) * 64 + vgo[i]); } while (0)
#define AT_WRITE(buf_) do { _Pragma("unroll") for (int i = 0; i < NKL; ++i) *(LAS u32x4*)(lds + (buf_) * BUF + klo[i]) = kst[i]; \
        _Pragma("unroll") for (int i = 0; i < 2; ++i) *(LAS u32x4*)(lds + (buf_) * BUF + vlo[i]) = vst[i]; } while (0)
    AT_LOAD(0); AT_WRITE(0);
    __syncthreads();
    for (int t = 0; t < nkt; ++t) {
        const bool more = (t + 1 < nkt);
        if (more) AT_LOAD(t + 1);
        if (t <= wave_last) {
            const LAS unsigned char* kb = lds + (t & 1) * BUF; const LAS unsigned char* vb = kb + KBYTES;
            f32x4 st[QF][4];
#pragma unroll
            for (int qf = 0; qf < QF; ++qf)
#pragma unroll
                for (int m = 0; m < 4; ++m) st[qf][m] = (f32x4){0.f, 0.f, 0.f, 0.f};
#pragma unroll
            for (int s = 0; s < KS; ++s)
#pragma unroll
                for (int m = 0; m < 4; ++m) {
                    const bf16x8 kf = *(const LAS bf16x8*)(kb + (16 * m + fr) * KROW + s * 64 + fq * 16);
#pragma unroll
                    for (int qf = 0; qf < QF; ++qf) st[qf][m] = __builtin_amdgcn_mfma_f32_16x16x32_bf16(kf, qreg[qf][s], st[qf][m], 0, 0, 0);
                }
            bf16x8 pb[QF][2];
#pragma unroll
            for (int qf = 0; qf < QF; ++qf) {
                float mx = st[qf][0][0];
#pragma unroll
                for (int m = 0; m < 4; ++m)
#pragma unroll
                    for (int j = 0; j < 4; ++j) mx = fmaxf(mx, st[qf][m][j]);
                mx = xor16_max(mx); mx = xor32_max(mx);
                const float mnew = fmaxf(mrun[qf], mx), alpha = __builtin_amdgcn_exp2f(mrun[qf] - mnew);
                mrun[qf] = mnew;
                float ps = 0.f; float p[4][4];
#pragma unroll
                for (int m = 0; m < 4; ++m)
#pragma unroll
                    for (int j = 0; j < 4; ++j) { p[m][j] = __builtin_amdgcn_exp2f(st[qf][m][j] - mnew); ps += p[m][j]; }
                lrun[qf] = lrun[qf] * alpha + ps;
#pragma unroll
                for (int mv = 0; mv < 8; ++mv) o[qf][mv] = o[qf][mv] * alpha;
#pragma unroll
                for (int s2 = 0; s2 < 2; ++s2) {
                    u32x4 w; w.x = pk2(p[2 * s2][0], p[2 * s2][1]); w.y = pk2(p[2 * s2][2], p[2 * s2][3]); w.z = pk2(p[2 * s2 + 1][0], p[2 * s2 + 1][1]); w.w = pk2(p[2 * s2 + 1][2], p[2 * s2 + 1][3]);
                    pb[qf][s2] = __builtin_bit_cast(bf16x8, w);
                }
            }
#pragma unroll
            for (int s2 = 0; s2 < 2; ++s2)
#pragma unroll
                for (int mv = 0; mv < 8; ++mv) {
                    const LAS unsigned char* vp = vb + (16 * mv + fr) * VROW + (32 * s2 + 4 * fq) * 2;
                    const u32x2 v0 = *(const LAS u32x2*)vp, v1 = *(const LAS u32x2*)(vp + 32);
                    u32x4 vv; vv.x = v0.x; vv.y = v0.y; vv.z = v1.x; vv.w = v1.y;
                    const bf16x8 vf = __builtin_bit_cast(bf16x8, vv);
#pragma unroll
                    for (int qf = 0; qf < QF; ++qf) o[qf][mv] = __builtin_amdgcn_mfma_f32_16x16x32_bf16(vf, pb[qf][s2], o[qf][mv], 0, 0, 0);
                }
        }
        if (more) AT_WRITE((t + 1) & 1);
        __syncthreads();
    }
#undef AT_LOAD
#undef AT_WRITE
#pragma unroll
    for (int qf = 0; qf < QF; ++qf) {
        float l = lrun[qf]; l = xor16_sum(l); l = xor32_sum(l);
        const float inv = 1.f / l;
        bf16_t* op = Op + (size_t)(16 * QF * wid + 16 * qf + fr) * ldo + 4 * fq;
#pragma unroll
        for (int mv = 0; mv < 8; ++mv) { u32x2 w; w.x = pk2(o[qf][mv][0] * inv, o[qf][mv][1] * inv); w.y = pk2(o[qf][mv][2] * inv, o[qf][mv][3] * inv); *(u32x2*)(op + 16 * mv) = w; }
    }
}

template <int DQK, int QF>
__device__ __forceinline__ void attn_unit_dma(LAS unsigned char* lds, const bf16_t* Qp, int ldq, const bf16_t* Kp, int ldk, const bf16_t* VTp, int ldvt, bf16_t* Op, int ldo, int nkt, int wave_last, const float* qgam, float qscale) {
    constexpr int KS = DQK / 32, KROW = DQK * 2 + 16, VROW = 144, KBYTES = 64 * KROW, VBYTES = 128 * VROW, BUF = KBYTES + VBYTES;
    constexpr int KCPR = DQK / 8, NKL = (64 * KCPR) / 512;
    const int tid = threadIdx.x, wid = __builtin_amdgcn_readfirstlane(tid >> 6), lane = tid & 63, fr = lane & 15, fq = lane >> 4;
    bf16x8 qreg[QF][KS];
#pragma unroll
    for (int qf = 0; qf < QF; ++qf)
#pragma unroll
        for (int s = 0; s < KS; ++s) qreg[qf][s] = *(const bf16x8*)(Qp + (size_t)(16 * QF * wid + 16 * qf + fr) * ldq + s * 32 + fq * 8);
    if (qgam) {
#pragma unroll
        for (int qf = 0; qf < QF; ++qf) {
            float sq = 0.f;
#pragma unroll
            for (int s = 0; s < KS; ++s)
#pragma unroll
                for (int e = 0; e < 8; ++e) { const float v = bf2f((bf16_t)qreg[qf][s][e]); sq += v * v; }
            sq = xor16_sum(sq); sq = xor32_sum(sq);
            const float r = rsqrtf(sq * (1.f / DQK) + EPS) * qscale;
#pragma unroll
            for (int s = 0; s < KS; ++s) {
                const f32x4 g0 = *(const f32x4*)(qgam + s * 32 + fq * 8), g1 = *(const f32x4*)(qgam + s * 32 + fq * 8 + 4); u32x4 w;
                w.x = pk2(bf2f((bf16_t)qreg[qf][s][0]) * r * g0[0], bf2f((bf16_t)qreg[qf][s][1]) * r * g0[1]); w.y = pk2(bf2f((bf16_t)qreg[qf][s][2]) * r * g0[2], bf2f((bf16_t)qreg[qf][s][3]) * r * g0[3]);
                w.z = pk2(bf2f((bf16_t)qreg[qf][s][4]) * r * g1[0], bf2f((bf16_t)qreg[qf][s][5]) * r * g1[1]); w.w = pk2(bf2f((bf16_t)qreg[qf][s][6]) * r * g1[2], bf2f((bf16_t)qreg[qf][s][7]) * r * g1[3]);
                qreg[qf][s] = __builtin_bit_cast(bf16x8, w);
            }
        }
    }
    f32x4 o[QF][8];
#pragma unroll
    for (int qf = 0; qf < QF; ++qf)
#pragma unroll
        for (int mv = 0; mv < 8; ++mv) o[qf][mv] = (f32x4){0.f, 0.f, 0.f, 0.f};
    float mrun[QF], lrun[QF];
#pragma unroll
    for (int qf = 0; qf < QF; ++qf) { mrun[qf] = -1e30f; lrun[qf] = 0.f; }
    constexpr int NKI = KBYTES / 1024, NVI = VBYTES / 1024, NIT = NKI + NVI, NJ = (NIT + 7) / 8, KCH = KROW / 16, VCH = VROW / 16;
    static_assert(KBYTES % 1024 == 0 && VBYTES % 1024 == 0, "slot image is whole 1 KiB pieces");
    int goff[NJ];
#pragma unroll
    for (int j = 0; j < NJ; ++j) {
        const int g = wid + 8 * j;
        if (g < NKI) { const int q = g * 64 + lane; int row = q / KCH, cc = q % KCH; if (cc == KCH - 1) cc = KCH - 2; goff[j] = row * ldk + cc * 8; }
        else { const int q = (g - NKI) * 64 + lane; int row = q / VCH, cc = q % VCH; if (cc == VCH - 1) cc = VCH - 2; goff[j] = row * ldvt + cc * 8; }
    }
    const bool full = (wid + 8 * (NJ - 1)) < NIT;
#define AT_DMA(t_, slot_) do { _Pragma("unroll") for (int j = 0; j < NJ; ++j) { const int g = wid + 8 * j; if (g < NIT) { \
        const bf16_t* src_ = (g < NKI) ? (Kp + (size_t)(t_) * 64 * ldk + goff[j]) : (VTp + (size_t)(t_) * 64 + goff[j]); \
        __builtin_amdgcn_global_load_lds((const unsigned*)src_, (LAS unsigned*)(lds + (slot_) * BUF + g * 1024), 16, 0, 0); } } } while (0)
#define AT_WAIT_KEEP1() do { if (full) asm volatile("s_waitcnt vmcnt(%0)" :: "n"(NJ) : "memory"); else asm volatile("s_waitcnt vmcnt(%0)" :: "n"(NJ - 1) : "memory"); } while (0)
#define AT_WAIT_ALL() asm volatile("s_waitcnt vmcnt(0)" ::: "memory")
    asm volatile("s_waitcnt vmcnt(0)" ::: "memory");
    AT_DMA(0, 0);
    if (nkt > 1) { AT_DMA(1, 1); AT_WAIT_KEEP1(); } else AT_WAIT_ALL();
    __builtin_amdgcn_s_barrier();
    int slot = 0;
    for (int t = 0; t < nkt; ++t) {
        const int s2slot = (slot == 0) ? 2 : slot - 1;
        if (t + 2 < nkt) AT_DMA(t + 2, s2slot);
        if (t <= wave_last) {
            const LAS unsigned char* kb = lds + slot * BUF; const LAS unsigned char* vb = kb + KBYTES;
            f32x4 st[QF][4];
#pragma unroll
            for (int qf = 0; qf < QF; ++qf)
#pragma unroll
                for (int m = 0; m < 4; ++m) st[qf][m] = (f32x4){0.f, 0.f, 0.f, 0.f};
            {
                bf16x8 kf[2][4];
#pragma unroll
                for (int m = 0; m < 4; ++m) kf[0][m] = *(const LAS bf16x8*)(kb + (16 * m + fr) * KROW + fq * 16);
#pragma unroll
                for (int s = 0; s < KS; ++s) {
                    if (s + 1 < KS) {
#pragma unroll
                        for (int m = 0; m < 4; ++m) kf[(s + 1) & 1][m] = *(const LAS bf16x8*)(kb + (16 * m + fr) * KROW + (s + 1) * 64 + fq * 16);
                    }
                    __builtin_amdgcn_sched_group_barrier(0x100, 4, 0);
                    __builtin_amdgcn_sched_group_barrier(0x008, 4 * QF, 0);
#pragma unroll
                    for (int m = 0; m < 4; ++m)
#pragma unroll
                        for (int qf = 0; qf < QF; ++qf) st[qf][m] = __builtin_amdgcn_mfma_f32_16x16x32_bf16(kf[s & 1][m], qreg[qf][s], st[qf][m], 0, 0, 0);
                }
            }
            bf16x8 pb[QF][2];
#pragma unroll
            for (int qf = 0; qf < QF; ++qf) {
                float mx = st[qf][0][0];
#pragma unroll
                for (int m = 0; m < 4; ++m)
#pragma unroll
                    for (int j = 0; j < 4; ++j) mx = fmaxf(mx, st[qf][m][j]);
                mx = xor16_max(mx); mx = xor32_max(mx);
                const float mnew = fmaxf(mrun[qf], mx), alpha = __builtin_amdgcn_exp2f(mrun[qf] - mnew);
                mrun[qf] = mnew;
                float ps = 0.f; float p[4][4];
#pragma unroll
                for (int m = 0; m < 4; ++m)
#pragma unroll
                    for (int j = 0; j < 4; ++j) { p[m][j] = __builtin_amdgcn_exp2f(st[qf][m][j] - mnew); ps += p[m][j]; }
                lrun[qf] = lrun[qf] * alpha + ps;
#pragma unroll
                for (int mv = 0; mv < 8; ++mv) o[qf][mv] = o[qf][mv] * alpha;
#pragma unroll
                for (int s2 = 0; s2 < 2; ++s2) {
                    u32x4 w; w.x = pk2(p[2 * s2][0], p[2 * s2][1]); w.y = pk2(p[2 * s2][2], p[2 * s2][3]); w.z = pk2(p[2 * s2 + 1][0], p[2 * s2 + 1][1]); w.w = pk2(p[2 * s2 + 1][2], p[2 * s2 + 1][3]);
                    pb[qf][s2] = __builtin_bit_cast(bf16x8, w);
                }
            }
            {
                u32x2 vr[2][4][2];
#define AT_VLOAD(buf_, grp_) do { _Pragma("unroll") for (int i = 0; i < 4; ++i) { const int s2_ = (grp_) >> 1, mv_ = ((grp_) & 1) * 4 + i; \
                    const LAS unsigned char* vp = vb + (16 * mv_ + fr) * VROW + (32 * s2_ + 4 * fq) * 2; \
                    vr[buf_][i][0] = *(const LAS u32x2*)vp; vr[buf_][i][1] = *(const LAS u32x2*)(vp + 32); } } while (0)
                AT_VLOAD(0, 0);
#pragma unroll
                for (int grp = 0; grp < 4; ++grp) {
                    if (grp + 1 < 4) AT_VLOAD((grp + 1) & 1, grp + 1);
                    __builtin_amdgcn_sched_group_barrier(0x100, 8, 0);
                    __builtin_amdgcn_sched_group_barrier(0x008, 4 * QF, 0);
#pragma unroll
                    for (int i = 0; i < 4; ++i) {
                        const int s2 = grp >> 1, mv = (grp & 1) * 4 + i;
                        u32x4 vv; vv.x = vr[grp & 1][i][0].x; vv.y = vr[grp & 1][i][0].y; vv.z = vr[grp & 1][i][1].x; vv.w = vr[grp & 1][i][1].y;
                        const bf16x8 vf = __builtin_bit_cast(bf16x8, vv);
#pragma unroll
                        for (int qf = 0; qf < QF; ++qf) o[qf][mv] = __builtin_amdgcn_mfma_f32_16x16x32_bf16(vf, pb[qf][s2], o[qf][mv], 0, 0, 0);
                    }
                }
#undef AT_VLOAD
            }
        }
        asm volatile("s_waitcnt lgkmcnt(0)" ::: "memory");
        if (t + 2 < nkt) AT_WAIT_KEEP1(); else AT_WAIT_ALL();
        __builtin_amdgcn_s_barrier();
        slot = (slot == 2) ? 0 : slot + 1;
    }
#undef AT_DMA
#undef AT_WAIT_KEEP1
#undef AT_WAIT_ALL
#pragma unroll
    for (int qf = 0; qf < QF; ++qf) {
        float l = lrun[qf]; l = xor16_sum(l); l = xor32_sum(l);
        const float inv = 1.f / l;
        bf16_t* op = Op + (size_t)(16 * QF * wid + 16 * qf + fr) * ldo + 4 * fq;
#pragma unroll
        for (int mv = 0; mv < 8; ++mv) { u32x2 w; w.x = pk2(o[qf][mv][0] * inv, o[qf][mv][1] * inv); w.y = pk2(o[qf][mv][2] * inv, o[qf][mv][3] * inv); *(u32x2*)(op + 16 * mv) = w; }
    }
}

#define XB_TMO      128
#define XB_XCNT(j)  (256  + 64 * (j))
#define XB_XSUB(j)  (1280 + 64 * (j))
#define XB_XGEN(j)  (2304 + 64 * (j))
#define XB_TOP      3328
#define XB_TOPGEN   3392
#define XCD_BAR_WORDS 3456
#define XB_SPIN_CAP (1u << 18)

__device__ __forceinline__ unsigned xb_ld(unsigned* p)              { return __hip_atomic_load(p, __ATOMIC_RELAXED, __HIP_MEMORY_SCOPE_AGENT); }
__device__ __forceinline__ unsigned xb_add(unsigned* p, unsigned v) { return __hip_atomic_fetch_add(p, v, __ATOMIC_RELAXED, __HIP_MEMORY_SCOPE_AGENT); }
__device__ __forceinline__ unsigned xb_xcc_id() { return (unsigned)__builtin_amdgcn_s_getreg((3 << 11) | 20) & 0xFu; }
#define XB_SPIN(cond, bar) do { unsigned _sp = 0; while (cond) { __builtin_amdgcn_s_sleep(1); \
    if ((++_sp & 255u) == 0u) { if (xb_ld(&(bar)[XB_TMO])) break; if (_sp > XB_SPIN_CAP) { atomicAdd(&(bar)[XB_TMO], 1u); break; } } } } while (0)

struct XcdBarrier {
    unsigned* bar; unsigned x;
    volatile LAS unsigned* st;
};

__device__ __forceinline__ XcdBarrier xcd_barrier_post(unsigned* bar, volatile LAS unsigned* st) {
    XcdBarrier b; b.bar = bar; b.x = xb_xcc_id(); b.st = st;
    if (threadIdx.x == 0) (void)xb_add(&bar[XB_XCNT(b.x)], 1u);
    return b;
}
__device__ __forceinline__ void xcd_barrier_complete(unsigned* bar, unsigned x, unsigned& nloc, unsigned& nx) {
    const unsigned G = gridDim.x * gridDim.y * gridDim.z;
    unsigned sum, cnt, mine, sp = 0u;
    for (;;) {
        sum = 0u; cnt = 0u; mine = 0u;
#pragma unroll
        for (unsigned j = 0; j < 16; ++j) { const unsigned c = xb_ld(&bar[XB_XCNT(j)]); sum += c; cnt += (c > 0u) ? 1u : 0u; mine = (j == x) ? c : mine; }
        if (sum == G) break;
        __builtin_amdgcn_s_sleep(1);
        if ((++sp & 255u) == 0u) { if (xb_ld(&bar[XB_TMO])) break; if (sp > XB_SPIN_CAP) { atomicAdd(&bar[XB_TMO], 1u); break; } }
    }
    nloc = mine > 0u ? mine : 1u; nx = cnt > 0u ? cnt : 1u;
}

__device__ __forceinline__ void xcd_barrier(const XcdBarrier& b) {
    asm volatile("s_waitcnt vmcnt(0)" ::: "memory");
    __syncthreads();
    if (threadIdx.x == 0) {
        unsigned* bar = b.bar;
        __builtin_amdgcn_s_waitcnt(0);
        unsigned nloc = b.st[0], nx = b.st[1];
        if (nloc == 0u) { xcd_barrier_complete(bar, b.x, nloc, nx); b.st[0] = nloc; b.st[1] = nx; }
        const unsigned old = xb_add(&bar[XB_XSUB(b.x)], 1u);
        const unsigned gen = old / nloc;
        if (old + 1u == (gen + 1u) * nloc) {
            __builtin_amdgcn_fence(__ATOMIC_RELEASE, "agent");
            asm volatile("s_waitcnt vmcnt(0)" ::: "memory");
            const unsigned og = xb_add(&bar[XB_TOP], 1u);
            const unsigned tg = og / nx;
            if (og + 1u == (tg + 1u) * nx) xb_add(&bar[XB_TOPGEN], 1u);
            else XB_SPIN(xb_ld(&bar[XB_TOPGEN]) == tg, bar);
            __builtin_amdgcn_fence(__ATOMIC_ACQUIRE, "agent");
            xb_add(&bar[XB_XGEN(b.x)], 1u);
            asm volatile("s_waitcnt vmcnt(0)" ::: "memory");
        } else {
            XB_SPIN(xb_ld(&bar[XB_XGEN(b.x)]) == gen, bar);
            __builtin_amdgcn_fence(__ATOMIC_ACQUIRE, "agent");
            asm volatile("s_waitcnt vmcnt(0)" ::: "memory");
        }
    }
    __syncthreads();
}


__device__ __forceinline__ void grid_barrier(unsigned* bar, unsigned epoch, unsigned G) {
    asm volatile("s_waitcnt vmcnt(0)" ::: "memory");
    __syncthreads();
    if (threadIdx.x == 0) {
        __builtin_amdgcn_fence(__ATOMIC_RELEASE, "agent");
        asm volatile("s_waitcnt vmcnt(0)" ::: "memory");
        __hip_atomic_fetch_add(bar + 32 * (blockIdx.x & 7), 1u, __ATOMIC_RELAXED, __HIP_MEMORY_SCOPE_AGENT);
        const unsigned base = G >> 3, rem = G & 7;
        for (;;) {
            unsigned c[8]; bool ok = true;
#pragma unroll
            for (int i = 0; i < 8; ++i) c[i] = __hip_atomic_load(bar + 32 * i, __ATOMIC_RELAXED, __HIP_MEMORY_SCOPE_AGENT);
#pragma unroll
            for (int i = 0; i < 8; ++i) ok = ok && (c[i] >= epoch * (base + ((unsigned)i < rem ? 1u : 0u)));
            if (ok) break;
            __builtin_amdgcn_s_sleep(1);
        }
        __builtin_amdgcn_fence(__ATOMIC_ACQUIRE, "agent");
        asm volatile("s_waitcnt vmcnt(0)" ::: "memory");
    }
    __syncthreads();
}

__global__ void __launch_bounds__(512, 2) mega_fwd(Args args) {
    extern __shared__ __attribute__((aligned(16))) unsigned char lds_raw[];
    LAS unsigned char* lds = (LAS unsigned char*)lds_raw;
    const int tid = threadIdx.x, lane = tid & 63, wave = __builtin_amdgcn_readfirstlane(tid >> 6);
    const int G = gridDim.x, cu = blockIdx.x;
    const int gw = cu * 8 + wave, NGW = G * 8;
    unsigned char* ws = args.ws;
    const float* x = args.in[0]; const float* mem = args.in[1]; const int* positions = (const int*)args.in[2];
    float* out = args.out;
    bf16_t* WGU = (bf16_t*)(ws + WS_WGU); bf16_t* WD = (bf16_t*)(ws + WS_WD); bf16_t* WIN = (bf16_t*)(ws + WS_WIN); bf16_t* WOUT = (bf16_t*)(ws + WS_WOUT);
    bf16_t* WMKV = (bf16_t*)(ws + WS_WMKV); bf16_t* WMQ = (bf16_t*)(ws + WS_WMQ); bf16_t* WMO = (bf16_t*)(ws + WS_WMO); bf16_t* WQUP = (bf16_t*)(ws + WS_WQUP); bf16_t* WKVUP = (bf16_t*)(ws + WS_WKVUP);
    bf16_t* H = (bf16_t*)(ws + WS_H); bf16_t* CAT = H; bf16_t* ACT = (bf16_t*)(ws + WS_ACT);
    bf16_t* Z = (bf16_t*)(ws + WS_Z); bf16_t* GVT = (bf16_t*)(ws + WS_GVT); bf16_t* QA = (bf16_t*)(ws + WS_QA); bf16_t* KVA = (bf16_t*)(ws + WS_KVA);
    bf16_t* KDT = (bf16_t*)(ws + WS_KDT); float* DEC = (float*)(ws + WS_DEC); bf16_t* MK = (bf16_t*)(ws + WS_MK); bf16_t* MVT = (bf16_t*)(ws + WS_MVT);
    bf16_t* Qb = (bf16_t*)(ws + WS_Q); bf16_t* Kb = (bf16_t*)(ws + WS_K); bf16_t* VT = (bf16_t*)(ws + WS_VT); bf16_t* MEMN = (bf16_t*)(ws + WS_MEMN);
    bf16_t* MQ = (bf16_t*)(ws + WS_MQ); bf16_t* OMEM = (bf16_t*)(ws + WS_OMEM); bf16_t* OG = (bf16_t*)(ws + WS_OG);
    LAS float* scr = (LAS float*)(lds + wave * 16384);

    const int lo = args.ph_lo, hi = args.ph_hi;
#ifndef PH_MASK
#define PH_MASK 0x3ffff
#endif
#define IN(k) (((PH_MASK >> (k)) & 1) && lo <= (k) && (k) < hi)
    unsigned* const gbar = (unsigned*)(ws + WS_BAR); unsigned epoch = 0;
    volatile LAS unsigned* xst = (volatile LAS unsigned*)(lds + 132608);
    if (tid < 4) xst[tid] = 0u;
    __syncthreads();
    const XcdBarrier xbar = xcd_barrier_post(gbar, xst);
#define SEAM(k) do { if (IN(k) && IN((k) + 1)) { xcd_barrier(xbar); } } while (0)
#define CVT_DEC(J, W_, K_, N_, DST_, KIND_, GAM_) if (!J.ok) { const int ni = cvt_nitems(K_, N_); if (r < ni) { J.W = W_; J.WT = DST_; J.gam = GAM_; J.K = K_; J.N = N_; J.kind = KIND_; J.item = r; J.ok = true; } else r -= ni; }
    float* SS1 = (float*)(ws + WS_SS); float* SS2 = SS1 + T; float* SS3 = SS2 + T; bf16_t* XB2 = (bf16_t*)(ws + WS_XB2);
    const float* nogam = nullptr;

    if (args.pad == 0x7fffffff) cg::this_grid().sync();
    if (IN(0)) {
#define CVT_DECODE_P0(J, it_) do { int r = (it_); J.ok = false; \
            CVT_DEC(J, args.in[4], D, FF, WGU, 1, nogam) CVT_DEC(J, args.in[5], D, FF, WGU, 2, nogam) CVT_DEC(J, args.in[6], FF, D, WD, 0, nogam) \
            CVT_DEC(J, args.in[8], D, 3920, WIN, 3, args.in[7]) CVT_DEC(J, args.in[10], 512, 1536, WQUP, 0, nogam) CVT_DEC(J, args.in[12], 256, 2048, WKVUP, 4, nogam) \
            CVT_DEC(J, args.in[18], D, D, WOUT, 0, nogam) CVT_DEC(J, args.in[21], D, 512, WMQ, 0, args.in[19]) CVT_DEC(J, args.in[22], D, 512, WMKV, 0, nogam) \
            CVT_DEC(J, args.in[23], D, 512, WMKV, 5, nogam) CVT_DEC(J, args.in[24], 512, D, WMO, 0, nogam) } while (0)
        {
            CvtJob cur, nxt; f32x4 cv[8]; int it = cu;
            CVT_DECODE_P0(cur, it); if (cur.ok) cvt_load(cur, cv, wave, lane);
            while (cur.ok) {
                cvt_to_lds(cv, lds, wave, lane);
                __syncthreads();
                it += G; CVT_DECODE_P0(nxt, it); if (nxt.ok) cvt_load(nxt, cv, wave, lane);
                cvt_from_lds(cur, lds, tid);
                __syncthreads();
                cur = nxt;
            }
        }
        {
            u32x4* zp = (u32x4*)(WIN + (size_t)ZUSED * D); const int nz = (ZLD - ZUSED) * D * 2 / 16;
            for (int i = cu * 512 + tid; i < nz; i += G * 512) zp[i] = (u32x4){0u, 0u, 0u, 0u};
            for (int i = cu * 512 + tid; i < 3 * T; i += G * 512) SS1[i] = 0.f;
        }
        for (int m = gw; m < T; m += NGW) rms_row2048(x + (size_t)m * D, args.in[3], H + (size_t)m * D, lane);
    }
    SEAM(0);
#ifndef EXTRA_SYNCS
#define EXTRA_SYNCS 0
#endif
#pragma unroll 1
    for (int es = 0; es < EXTRA_SYNCS + args.ph_lo; ++es) grid_barrier(gbar, ++epoch, (unsigned)G);
    if (IN(1)) {
        pg8::Gemm g{H, WGU, D, D, D}; pg8::StaticOrder S; S.init(T, 2 * FF, G, cu);
        pg8::EpiSwiglu E{ACT, FF, nullptr};
        pg8::gemm_phase(lds, g, S, E);
    }
    SEAM(1);
    if (IN(2)) {
        pg8::Gemm g{ACT, WD, FF, FF, FF}; pg8::StaticOrder S; S.init(T, D, G, cu);
        pg8::EpiResid<1, true, WS_H, WS_SS> E{x, out, ws};
        pg8::gemm_phase(lds, g, S, E);
    }
    SEAM(2);
    if (IN(3)) {
        { pg8::Gemm g{H, WIN, D, D, D}; pg8::StaticOrder S; S.init(T, ZLD, G, cu); pg8::EpiStore E{Z, ZLD, 0, SS1, 1}; pg8::gemm_phase(lds, g, S, E); }
        { pg8::Gemm g{WIN + (size_t)ZLD * D, H, D, D, D}; pg8::StaticOrder S; S.init(1024, T, G, cu); pg8::EpiStore E{GVT, T, 3, SS1, 2}; pg8::gemm_phase(lds, g, S, E); }
    }
    SEAM(3);
    if (IN(4)) {
#ifndef DUP_GLAPREP
#define DUP_GLAPREP 0
#endif
#pragma unroll 1
        for (int rep = 0; rep < args.ph_lo + 1 + DUP_GLAPREP; ++rep)
        for (int it = cu; it < NB * 32; it += G) gla_prep_item(lds, it, Z, args.in[15], args.in[16], KDT, DEC);
        u32x4 nzq, ngq; u32x2 nzkv;
#define P4_LOAD(m_) do { const bf16_t* zr_ = Z + (size_t)(m_) * ZLD; nzq = *(const u32x4*)(zr_ + ZQ + lane * 8); nzkv = *(const u32x2*)(zr_ + ZKV + lane * 4); \
            ngq = *(const u32x4*)(zr_ + ZGQ + (lane >> 4) * 128 + (lane & 15) * 8); } while (0)
        if (gw < T) P4_LOAD(gw);
        for (int m = gw; m < T; m += NGW) {
            const u32x4 czq = nzq, cgq = ngq; const u32x2 czkv = nzkv;
            if (m + NGW < T) P4_LOAD(m + NGW);
            {
                const int h_ = lane >> 4, pc = lane & 15, fr_ = m & 15, fw_ = (m >> 4) & 3, ch_ = (m >> 6) & 31, b_ = m >> 11;
                const u32x4 gqv = cgq;
                *(u32x4*)(H + ((((size_t)((b_ * 4 + h_) * 32 + ch_) * 4 + fw_) * 4 + (pc >> 2)) * 64 + (pc & 3) * 16 + fr_) * 8) = gqv;
            }
            {
                const u32x4 u = czq;
                float v[8] = {bflo(u.x), bfhi(u.x), bflo(u.y), bfhi(u.y), bflo(u.z), bfhi(u.z), bflo(u.w), bfhi(u.w)};
                float sq = 0.f;
#pragma unroll
                for (int e = 0; e < 8; ++e) sq += v[e] * v[e];
                const float r = rsqrtf(wave_sum(sq) * (1.f / 512.f) + EPS);
                const f32x4 g0 = *(const f32x4*)(args.in[9] + lane * 8), g1 = *(const f32x4*)(args.in[9] + lane * 8 + 4);
                u32x4 w; w.x = pk2(v[0] * r * g0.x, v[1] * r * g0.y); w.y = pk2(v[2] * r * g0.z, v[3] * r * g0.w); w.z = pk2(v[4] * r * g1.x, v[5] * r * g1.y); w.w = pk2(v[6] * r * g1.z, v[7] * r * g1.w);
                *(u32x4*)(QA + (size_t)m * 512 + lane * 8) = w;
            }
            {
                const u32x2 u = czkv;
                const float v0 = bflo(u.x), v1 = bfhi(u.x), v2 = bflo(u.y), v3 = bfhi(u.y);
                const float r = rsqrtf(wave_sum(v0 * v0 + v1 * v1 + v2 * v2 + v3 * v3) * (1.f / 256.f) + EPS);
                const f32x4 g0 = *(const f32x4*)(args.in[11] + lane * 4);
                u32x2 w; w.x = pk2(v0 * r * g0.x, v1 * r * g0.y); w.y = pk2(v2 * r * g0.z, v3 * r * g0.w);
                *(u32x2*)(KVA + (size_t)m * 256 + lane * 4) = w;
            }
        }
        for (int m = gw; m < NB * 256; m += NGW) rms_row2048(mem + (size_t)m * D, args.in[20], MEMN + (size_t)m * D, lane);
#define CVT_DECODE_P4(J, it_) do { int r = (it_); J.ok = false; \
            CVT_DEC(J, args.in[28], D, FF, WGU, 1, args.in[27]) CVT_DEC(J, args.in[29], D, FF, WGU, 2, args.in[27]) CVT_DEC(J, args.in[30], FF, D, WD, 0, nogam) } while (0)
#ifndef DUP_CVT4
#define DUP_CVT4 0
#endif
#pragma unroll 1
        for (int rep = 0; rep < args.ph_lo + 1 + DUP_CVT4; ++rep)
        {
            CvtJob cur, nxt; f32x4 cv[8]; int it = cu;
            CVT_DECODE_P4(cur, it); if (cur.ok) cvt_load(cur, cv, wave, lane);
            while (cur.ok) {
                cvt_to_lds(cv, lds, wave, lane);
                __syncthreads();
                it += G; CVT_DECODE_P4(nxt, it); if (nxt.ok) cvt_load(nxt, cv, wave, lane);
                cvt_from_lds(cur, lds, tid);
                __syncthreads();
                cur = nxt;
            }
        }
    }
    SEAM(4);
    if (IN(5)) {
        { pg8::Gemm g{QA, WQUP, 512, 512, 512}; pg8::StaticOrder S; S.init(T, 1536, G, cu); pg8::EpiStore E{Qb, 1536, 0, nullptr, 0}; pg8::gemm_phase(lds, g, S, E); }
        { pg8::Gemm g{KVA, WKVUP, 256, 256, 256}; pg8::StaticOrder S; if ((G & 15) == 0) S.init(T, 1024, G / 2, cu >= G / 2 ? cu - G / 2 : (1 << 20)); else S.init(T, 1024, G, cu); pg8::EpiStore E{Kb, 1536, 1, nullptr, 0}; pg8::gemm_phase(lds, g, S, E); }
        { pg8::Gemm g{WKVUP + (size_t)1024 * 256, KVA, 256, 256, 256}; pg8::StaticOrder S; S.init(1024, T, G, cu); pg8::EpiStore E{VT, T, 0, nullptr, 0}; pg8::gemm_phase(lds, g, S, E); }
    }
    SEAM(5);
    if (IN(6)) {
#ifndef DUP_GLA
#define DUP_GLA 0
#endif
#pragma unroll 1
        for (int rep = 0; rep < args.ph_lo + 1 + DUP_GLA; ++rep)
        for (int it = cu; it < 256; it += G) gla_item(lds, ((it & 7) * 4 + (it >> 6)) * 8 + ((it >> 3) & 7), KDT, DEC, GVT, H, OG);
#ifndef DUP_MLAPREP
#define DUP_MLAPREP 0
#endif
#pragma unroll 1
        for (int rep = 0; rep < args.ph_lo + 1 + DUP_MLAPREP; ++rep)
        {
            const int hh = lane >> 3, jj = lane & 7;
            const float* gqn = args.in[13]; const float* gkn = args.in[14];
            f32x4 gq[4], gk[4];
#pragma unroll
            for (int i = 0; i < 4; ++i) { gq[i] = *(const f32x4*)(gqn + 16 * jj + 4 * i); gk[i] = *(const f32x4*)(gkn + 16 * jj + 4 * i); }
            const f32x4 gq1 = *(const f32x4*)(gqn + 128 + 4 * jj), gq2 = *(const f32x4*)(gqn + 160 + 4 * jj), gk1 = *(const f32x4*)(gkn + 128 + 4 * jj), gk2 = *(const f32x4*)(gkn + 160 + 4 * jj);
            float ifr[4];
#pragma unroll
            for (int e = 0; e < 4; ++e) ifr[e] = exp2f(-(float)(4 * jj + e) * (13.287712379549449f / 32.f));
            const float qsc = 0.07216878364870322f * LOG2E;
            u32x4 nqa0, nqa1, nka0, nka1; u32x2 nqr1, nqr2, nkr1, nkr2; int npos;
#define MLAP_LOAD(m_) do { const bf16_t* qp_ = Qb + (size_t)(m_) * 1536 + hh * 192; const bf16_t* kp_ = Kb + (size_t)(m_) * 1536 + hh * 192; const bf16_t* zk_ = Z + (size_t)(m_) * ZLD + ZKR; \
                nqa0 = *(const u32x4*)(qp_ + 16 * jj); nqa1 = *(const u32x4*)(qp_ + 16 * jj + 8); nqr1 = *(const u32x2*)(qp_ + 128 + 4 * jj); nqr2 = *(const u32x2*)(qp_ + 160 + 4 * jj); \
                nka0 = *(const u32x4*)(kp_ + 16 * jj); nka1 = *(const u32x4*)(kp_ + 16 * jj + 8); nkr1 = *(const u32x2*)(zk_ + 4 * jj); nkr2 = *(const u32x2*)(zk_ + 32 + 4 * jj); npos = positions[m_]; } while (0)
            if (gw < T) MLAP_LOAD(gw);
            for (int m = gw; m < T; m += NGW) {
                bf16_t* qp = Qb + (size_t)m * 1536 + hh * 192; bf16_t* kp = Kb + (size_t)m * 1536 + hh * 192;
                const u32x4 qa0 = nqa0, qa1 = nqa1, ka0 = nka0, ka1 = nka1; const u32x2 qr1 = nqr1, qr2 = nqr2, kr1 = nkr1, kr2 = nkr2;
                const float pos = (float)npos;
                if (m + NGW < T) MLAP_LOAD(m + NGW);
                float cs[4], sn[4];
#pragma unroll
                for (int e = 0; e < 4; ++e) { const float ang = pos * ifr[e]; double rv = (double)ang * 0.15915494309189535; rv -= rint(rv); const float rf = (float)rv; cs[e] = __builtin_amdgcn_cosf(rf); sn[e] = __builtin_amdgcn_sinf(rf); }
#define MLAP_ONE(A0, A1, R1, R2, G, G1, G2, SC, DST) do { \
                    float v[16]; \
                    v[0] = bflo(A0.x); v[1] = bfhi(A0.x); v[2] = bflo(A0.y); v[3] = bfhi(A0.y); v[4] = bflo(A0.z); v[5] = bfhi(A0.z); v[6] = bflo(A0.w); v[7] = bfhi(A0.w); \
                    v[8] = bflo(A1.x); v[9] = bfhi(A1.x); v[10] = bflo(A1.y); v[11] = bfhi(A1.y); v[12] = bflo(A1.z); v[13] = bfhi(A1.z); v[14] = bflo(A1.w); v[15] = bfhi(A1.w); \
                    float x1[4] = {bflo(R1.x), bfhi(R1.x), bflo(R1.y), bfhi(R1.y)}, x2[4] = {bflo(R2.x), bfhi(R2.x), bflo(R2.y), bfhi(R2.y)}; \
                    float sq = 0.f; \
                    _Pragma("unroll") for (int i = 0; i < 16; ++i) sq += v[i] * v[i]; \
                    _Pragma("unroll") for (int e = 0; e < 4; ++e) sq += x1[e] * x1[e] + x2[e] * x2[e]; \
                    sq += dpp_mov<0xB1>(sq); sq += dpp_mov<0x4E>(sq); sq += dpp_mov<0x141>(sq); \
                    const float r = rsqrtf(sq * (1.f / 192.f) + EPS) * (SC); \
                    u32x4 w0, w1; \
                    w0.x = pk2(v[0] * r * G[0][0], v[1] * r * G[0][1]); w0.y = pk2(v[2] * r * G[0][2], v[3] * r * G[0][3]); w0.z = pk2(v[4] * r * G[1][0], v[5] * r * G[1][1]); w0.w = pk2(v[6] * r * G[1][2], v[7] * r * G[1][3]); \
                    w1.x = pk2(v[8] * r * G[2][0], v[9] * r * G[2][1]); w1.y = pk2(v[10] * r * G[2][2], v[11] * r * G[2][3]); w1.z = pk2(v[12] * r * G[3][0], v[13] * r * G[3][1]); w1.w = pk2(v[14] * r * G[3][2], v[15] * r * G[3][3]); \
                    float y1[4], y2[4]; \
                    _Pragma("unroll") for (int e = 0; e < 4; ++e) { const float a = x1[e] * r * G1[e], bq = x2[e] * r * G2[e]; y1[e] = a * cs[e] - bq * sn[e]; y2[e] = bq * cs[e] + a * sn[e]; } \
                    u32x2 o1, o2; o1.x = pk2(y1[0], y1[1]); o1.y = pk2(y1[2], y1[3]); o2.x = pk2(y2[0], y2[1]); o2.y = pk2(y2[2], y2[3]); \
                    *(u32x4*)(DST + 16 * jj) = w0; *(u32x4*)(DST + 16 * jj + 8) = w1; *(u32x2*)(DST + 128 + 4 * jj) = o1; *(u32x2*)(DST + 160 + 4 * jj) = o2; } while (0)
                MLAP_ONE(qa0, qa1, qr1, qr2, gq, gq1, gq2, qsc, qp);
                MLAP_ONE(ka0, ka1, kr1, kr2, gk, gk1, gk2, 1.f, kp);
#undef MLAP_ONE
#undef MLAP_LOAD
            }
        }
    }
    SEAM(6);
    if (IN(7)) {
        {
            const f32x4 gg = *(const f32x4*)(args.in[17] + lane * 4);
            u32x2 nu[4], nzu[4];
#define GLAP_LOAD(m_) do { _Pragma("unroll") for (int h = 0; h < 4; ++h) { \
                    nu[h] = *(const u32x2*)(OG + (size_t)((((m_) >> 11) * 4 + h) * 8 + (lane >> 3)) * (SEQ * 32) + (size_t)((m_) & 2047) * 32 + (lane & 7) * 4); \
                    nzu[h] = *(const u32x2*)(Z + (size_t)(m_) * ZLD + ZZR + h * 256 + lane * 4); } } while (0)
            if (gw < T) GLAP_LOAD(gw);
            for (int m = gw; m < T; m += NGW) {
                u32x2 u[4], zu[4];
#pragma unroll
                for (int h = 0; h < 4; ++h) { u[h] = nu[h]; zu[h] = nzu[h]; }
                if (m + NGW < T) GLAP_LOAD(m + NGW);
#pragma unroll
                for (int h = 0; h < 4; ++h) {
                    const float v0 = bflo(u[h].x), v1 = bfhi(u[h].x), v2 = bflo(u[h].y), v3 = bfhi(u[h].y);
                    const float r = rsqrtf(wave_sum(v0 * v0 + v1 * v1 + v2 * v2 + v3 * v3) * (1.f / 256.f) + EPS);
                    const float z0 = bflo(zu[h].x), z1 = bfhi(zu[h].x), z2 = bflo(zu[h].y), z3 = bfhi(zu[h].y);
                    u32x2 w; w.x = pk2(v0 * r * gg.x * fast_silu(z0), v1 * r * gg.y * fast_silu(z1));
                    w.y = pk2(v2 * r * gg.z * fast_silu(z2), v3 * r * gg.w * fast_silu(z3));
                    *(u32x2*)(CAT + (size_t)m * 2048 + 1024 + h * 256 + lane * 4) = w;
                }
            }
        }
        __syncthreads();
#ifndef MLA_QF
#define MLA_QF 2
#endif
        constexpr int QR = 128 * MLA_QF, NQB = SEQ / QR, NPAIR = NB * 8 * NQB / 2;
#ifndef DUP_ATT
#define DUP_ATT 0
#endif
#pragma unroll 1
        for (int rep = 0; rep < args.ph_lo + 1 + DUP_ATT; ++rep)
        for (int p = cu; p < NPAIR; p += G) {
            const int xcd_ = p & 7, idx_ = p >> 3, bh = (NPAIR % 8 == 0) ? xcd_ * (NPAIR / 8 / (NQB / 2)) + idx_ / (NQB / 2) : p / (NQB / 2), qp = (NPAIR % 8 == 0) ? idx_ % (NQB / 2) : p % (NQB / 2), b = bh >> 3, h = bh & 7;
#pragma unroll 1
            for (int half = 0; half < 2; ++half) {
                const int qb = half ? NQB - 1 - qp : qp;
                const size_t r0 = (size_t)b * SEQ + qb * QR;
                attn_unit_dma<192, MLA_QF>(lds, Qb + r0 * 1536 + h * 192, 1536, Kb + (size_t)b * SEQ * 1536 + h * 192, 1536, VT + (size_t)(h * 128) * T + (size_t)b * SEQ, T,
                               CAT + r0 * 2048 + h * 128, 2048, (QR / 64) * (qb + 1), (qb * QR + 16 * MLA_QF * wave) / 64, nullptr, 1.f);
            }
        }
    }
    SEAM(7);
    if (IN(8)) {
        pg8::Gemm g{CAT, WOUT, D, D, D}; pg8::StaticOrder S; S.init(T, D, G, cu);
        pg8::EpiResid<2, true, WS_XB2, WS_SS + (size_t)T * 4> E{out, out, ws};
        pg8::gemm_phase(lds, g, S, E);
    }
    SEAM(8);
    if (IN(9)) {
        { pg8::Gemm g{XB2, WMQ, D, D, D}; pg8::StaticOrder S; S.init(T, 512, G, cu); pg8::EpiStore E{MQ, 512, 0, SS2, 1}; pg8::gemm_phase(lds, g, S, E); }
        { pg8::Gemm g{MEMN, WMKV, D, D, D}; pg8::StaticOrder S; S.init(NB * 256, 512, G, (cu + 128) % G); pg8::EpiStore E{MK, 512, 0, nullptr, 0}; pg8::gemm_phase(lds, g, S, E); }
        { pg8::Gemm g{WMKV + (size_t)512 * D, MEMN, D, D, D}; pg8::StaticOrder S; S.init(512, NB * 256, G, (cu + 96) % G); pg8::EpiStore E{MVT, NB * 256, 0, nullptr, 0}; pg8::gemm_phase(lds, g, S, E); }
    }
    SEAM(9);
    if (IN(10)) {
        for (int it = gw; it < NB * 256 * 4; it += NGW) norm128(MK + (size_t)(it >> 2) * 512 + (it & 3) * 128, args.in[26], 1.f, lane);
        if (IN(9)) xcd_barrier(xbar);
    }
    if (IN(10)) {
        for (int u = cu; u < 256; u += G) {
            const int bhx = (u & 7) * 4 + (u >> 6), b = bhx >> 2, h = bhx & 3, qb = (u >> 3) & 7;
            const size_t r0 = (size_t)b * SEQ + qb * 256;
            attn_unit_dma<128, 2>(lds, MQ + r0 * 512 + h * 128, 512, MK + (size_t)b * 256 * 512 + h * 128, 512, MVT + (size_t)(h * 128) * (NB * 256) + b * 256, NB * 256,
                           OMEM + r0 * 512 + h * 128, 512, 4, 3, args.in[25], 0.08838834764831845f * LOG2E);
        }
    }
    SEAM(10);
    if (IN(11)) {
        pg8::Gemm g{OMEM, WMO, 512, 512, 512}; pg8::StaticOrder S; S.init(T, D, G, cu);
        pg8::EpiResid<2, true, WS_H, WS_SS + (size_t)T * 8> E{out, out, ws};
        pg8::gemm_phase(lds, g, S, E);
    }
    SEAM(11);
    if (IN(12)) {
        pg8::Gemm g{H, WGU, D, D, D}; pg8::StaticOrder S; S.init(T, 2 * FF, G, cu);
        pg8::EpiSwiglu E{ACT, FF, SS3};
        pg8::gemm_phase(lds, g, S, E);
    }
    SEAM(12);
    if (IN(13)) {
        pg8::Gemm g{ACT, WD, FF, FF, FF}; pg8::StaticOrder S; S.init(T, D, G, cu);
        pg8::EpiResid<1, false, 0, 0> E{out, out, ws};
        pg8::gemm_phase(lds, g, S, E);
    }
#undef IN
#undef SEAM
#undef CVT_DEC
}

constexpr int N_PHASES = 14;

extern "C" void kernel_launch(void* const* d_in, const int* in_sizes, int n_in, void* d_out, int out_size, void* d_ws, size_t ws_size, hipStream_t stream) {
    static int grid = 0;
    if (grid == 0) {
        if (n_in != 31 || ws_size < WS_END2) { fprintf(stderr, "kernel_launch: unexpected n_in %d or ws_size %zu (need %zu)\n", n_in, ws_size, (size_t)WS_END2); grid = -1; return; }
        int dev = 0, cus = 0, per_cu = 0;
        (void)hipGetDevice(&dev);
        (void)hipDeviceGetAttribute(&cus, hipDeviceAttributeMultiprocessorCount, dev);
        if (hipFuncSetAttribute((const void*)mega_fwd, hipFuncAttributeMaxDynamicSharedMemorySize, LDS_BYTES) != hipSuccess) { fprintf(stderr, "kernel_launch: hipFuncSetAttribute failed\n"); grid = -1; return; }
        if (hipOccupancyMaxActiveBlocksPerMultiprocessor(&per_cu, (const void*)mega_fwd, 512, LDS_BYTES) != hipSuccess || per_cu < 1) { fprintf(stderr, "kernel_launch: occupancy query says %d\n", per_cu); per_cu = 1; }
        (void)hipGetLastError();
        grid = cus * 1;
        fprintf(stderr, "kernel_launch: grid %d (cus %d, per_cu %d), ws %zu MiB\n", grid, cus, per_cu, ws_size >> 20);
    }
    if (grid < 0) return;
    Args a{};
    for (int i = 0; i < 31; ++i) a.in[i] = (const float*)d_in[i];
    a.out = (float*)d_out; a.ws = (unsigned char*)d_ws;
#if MK_N_LAUNCHES == 1
    (void)hipMemsetAsync((char*)d_ws + WS_BAR, 0, 16384, stream);
    a.ph_lo = 0; a.ph_hi = N_PHASES; a.rmask = RMASK;
    void* kargs[] = {&a};
    hipError_t e = hipLaunchCooperativeKernel((const void*)mega_fwd, dim3(grid), dim3(512), kargs, LDS_BYTES, stream);
    if (e != hipSuccess) fprintf(stderr, "cooperative launch failed: %s (grid %d)\n", hipGetErrorString(e), grid);
#else
#ifndef RUN_PHASES
#define RUN_PHASES 14
#endif
    for (int p = 0; p < RUN_PHASES; ++p) {
        const int pe = (p == 5) ? p + 1 : p;
        const int reps = 1 + ((RMASK >> p) & 1);
        for (int r = 0; r < reps; ++r)
            for (int q = p; q <= pe; ++q) { a.ph_lo = q; a.ph_hi = q + 1; hipLaunchKernelGGL(mega_fwd, dim3(grid), dim3(512), LDS_BYTES, stream, a); }
        p = pe;
    }
#endif
}
```

```cpp
#include <hip/hip_runtime.h>
#include <hip/hip_cooperative_groups.h>
#include <cstdio>
#include <cstdint>
namespace cg = cooperative_groups;

#ifndef RMASK
#define RMASK 0
#endif
#ifndef MK_N_LAUNCHES
#define MK_N_LAUNCHES 1
#endif

#define LAS __attribute__((address_space(3)))
typedef unsigned short bf16_t;
typedef short bf16x8 __attribute__((ext_vector_type(8)));
typedef short s16x4 __attribute__((ext_vector_type(4)));
typedef float f32x4 __attribute__((ext_vector_type(4)));
typedef unsigned u32x4 __attribute__((ext_vector_type(4)));
typedef unsigned u32x2 __attribute__((ext_vector_type(2)));

constexpr int NB = 8, SEQ = 2048, T = NB * SEQ, D = 2048, FF = 5632;
constexpr int ZLD = 3072;
constexpr int ZQ = 0, ZKV = 512, ZKR = 768, ZGQ = 832, ZGK = 1344, ZZG = 1856, ZZR = 1872, ZUSED = 2896;
constexpr float EPS = 1e-6f;
constexpr float LOG2E = 1.4426950408889634f;

constexpr size_t MiB = 1u << 20;
constexpr size_t WS_WGU = 0, WS_WD = 44 * MiB;
constexpr size_t WS_WIN = 66 * MiB, WS_WOUT = 82 * MiB, WS_WMKV = 90 * MiB, WS_WMQ = 94 * MiB, WS_WMO = 96 * MiB, WS_WQUP = 98 * MiB, WS_WKVUP = 100 * MiB;
constexpr size_t WS_H = 104 * MiB;
constexpr size_t WS_ACT = 168 * MiB;
constexpr size_t WS_Z = 168 * MiB, WS_GVT = 264 * MiB, WS_QA = 296 * MiB, WS_KVA = 312 * MiB, WS_KDT = 320 * MiB, WS_DEC = 336 * MiB, WS_MK = 337 * MiB, WS_MVT = 339 * MiB;
constexpr size_t WS_Q = 344 * MiB, WS_K = 392 * MiB, WS_VT = 440 * MiB, WS_MEMN = 472 * MiB, WS_END = 480 * MiB;
constexpr size_t WS_MQ = WS_VT, WS_OMEM = WS_VT + 16 * MiB;
constexpr size_t WS_XB2 = WS_Q;
constexpr size_t WS_BAR = 103 * MiB;
constexpr size_t WS_SS = 101 * MiB;
constexpr size_t WS_OG = 480 * MiB, WS_END2 = 512 * MiB;

constexpr int LDS_BYTES = 131072 + 2048;

typedef __bf16 bf16x2_t __attribute__((ext_vector_type(2)));
typedef float f32x2_t __attribute__((ext_vector_type(2)));
__device__ __forceinline__ unsigned pk2(float lo, float hi) { f32x2_t v = {lo, hi}; bf16x2_t b = __builtin_convertvector(v, bf16x2_t); return __builtin_bit_cast(unsigned, b); }
__device__ __forceinline__ bf16_t f2bf(float f) { return (bf16_t)(pk2(f, 0.f) & 0xffffu); }
__device__ __forceinline__ float bf2f(bf16_t u) { return __builtin_bit_cast(float, (unsigned)u << 16); }
__device__ __forceinline__ float bflo(unsigned u) { return __builtin_bit_cast(float, u << 16); }
__device__ __forceinline__ float bfhi(unsigned u) { return __builtin_bit_cast(float, u & 0xffff0000u); }
template <int CTRL> __device__ __forceinline__ float dpp_mov(float v) {
    return __builtin_bit_cast(float, __builtin_amdgcn_update_dpp(0, __builtin_bit_cast(int, v), CTRL, 0xF, 0xF, true));
}
__device__ __forceinline__ float wave_sum(float v) {
    v += dpp_mov<0xB1>(v);
    v += dpp_mov<0x4E>(v);
    v += dpp_mov<0x141>(v);
    v += dpp_mov<0x140>(v);
    const int iv = __builtin_bit_cast(int, v);
    const float r0 = __builtin_bit_cast(float, __builtin_amdgcn_readlane(iv, 0)), r1 = __builtin_bit_cast(float, __builtin_amdgcn_readlane(iv, 16));
    const float r2 = __builtin_bit_cast(float, __builtin_amdgcn_readlane(iv, 32)), r3 = __builtin_bit_cast(float, __builtin_amdgcn_readlane(iv, 48));
    return (r0 + r1) + (r2 + r3);
}
__device__ __forceinline__ void swap16(float& a, float& b) { asm("s_nop 1\n\tv_permlane16_swap_b32 %0, %1" : "+v"(a), "+v"(b)); }
__device__ __forceinline__ void swap32(float& a, float& b) { asm("s_nop 1\n\tv_permlane32_swap_b32 %0, %1" : "+v"(a), "+v"(b)); }
__device__ __forceinline__ float xor16_sum(float v) { float a = v, b = v; swap16(a, b); return a + b; }
__device__ __forceinline__ float xor32_sum(float v) { float a = v, b = v; swap32(a, b); return a + b; }
__device__ __forceinline__ float xor16_max(float v) { float a = v, b = v; swap16(a, b); return fmaxf(a, b); }
__device__ __forceinline__ float xor32_max(float v) { float a = v, b = v; swap32(a, b); return fmaxf(a, b); }
__device__ __forceinline__ float lane_xor32(float v, int lane) { float a = v, b = v; swap32(a, b); return lane < 32 ? b : a; }
__device__ __forceinline__ float fast_silu(float g) { return g * __builtin_amdgcn_rcpf(1.f + __expf(-g)); }

namespace pg8 {
constexpr int BM = 256, BK = 64, HALF = 128, HTB = HALF * BK * 2, STAGE_BYTES = 8 * HTB, NXCD = 8, WGM = 8;
__host__ __device__ __forceinline__ int lds_byte(int r, int c) { const int st = (r >> 4) * 2 + (c >> 5), rr = r & 15, cc = c & 31, ob = rr * 64 + cc * 2; return st * 1024 + (ob ^ (((ob >> 9) & 1) << 5)); }
__host__ __device__ __forceinline__ void stage_rc(int b, int& R, int& C) { const int st = b / 1024, sb = b % 1024, swz = sb ^ (((sb >> 9) & 1) << 5); R = (st >> 1) * 16 + swz / 64; C = (st & 1) * 32 + (swz % 64) / 2; }
__host__ __device__ __forceinline__ int perm32(int rho) { const int n = rho >> 4, i = rho & 15; return 8 * (i >> 2) + 4 * n + (i & 3); }

struct Unit { int pm, pn; };
struct Gemm { const bf16_t* A; const bf16_t* Bt; int lda, ldb, K; };

struct StaticOrder {
    int nM, nN, nwg, G, c;
    __device__ void init(int M, int N, int G_, int c_) { nM = M / BM; nN = N / BM; nwg = nM * nN; G = G_; c = c_; }
    __device__ bool next(int i, Unit& u) const {
        const long L = (long)i * G + c; if (L >= nwg) return false;
        int wgid = (int)L; { const int q = nwg / NXCD, r = nwg % NXCD, xcd = wgid % NXCD, off = wgid / NXCD; wgid = (xcd < r ? xcd * (q + 1) : r * (q + 1) + (xcd - r) * q) + off; }
        const int nig = WGM * nN, gid = wgid / nig, fm = gid * WGM, gsz = (nM - fm) < WGM ? (nM - fm) : WGM;
        u.pm = fm + ((wgid % nig) % gsz); u.pn = (wgid % nig) / gsz; return true;
    }
};

struct EpiStore {
    bf16_t* O; int ldc; int remap; const float* ss; int smode;
    __device__ __forceinline__ void operator()(const f32x4 (&acc)[2][2][4][2], const Unit& u, int wr, int wc, int fr, int fq) const {
        const int row0 = u.pm * BM + wr * 64 + fr;
#pragma unroll
        for (int bj = 0; bj < 2; ++bj) {
            const int c = u.pn * BM + bj * HALF + wc * 32 + 8 * fq; const int dc = remap ? (c >> 7) * 192 + (c & 127) : c;
            f32x4 cs0 = (f32x4){1.f, 1.f, 1.f, 1.f}, cs1 = cs0;
            if (smode == 2) { const f32x4 t0 = *(const f32x4*)(ss + c), t1 = *(const f32x4*)(ss + c + 4);
#pragma unroll
                for (int e = 0; e < 4; ++e) { cs0[e] = rsqrtf(t0[e] * (1.f / 2048.f) + EPS); cs1[e] = rsqrtf(t1[e] * (1.f / 2048.f) + EPS); } }
#pragma unroll
            for (int ai = 0; ai < 2; ++ai)
#pragma unroll
                for (int m = 0; m < 4; ++m) {
                    const int row = row0 + ai * HALF + m * 16;
                    const float rs = (smode == 1) ? rsqrtf(ss[row] * (1.f / 2048.f) + EPS) : 1.f;
                    const f32x4 v0 = acc[ai][bj][m][0] * cs0 * rs, v1 = acc[ai][bj][m][1] * cs1 * rs; u32x4 w;
                    w.x = pk2(v0[0], v0[1]); w.y = pk2(v0[2], v0[3]); w.z = pk2(v1[0], v1[1]); w.w = pk2(v1[2], v1[3]);
                    size_t off = (size_t)row * ldc + dc;
                    if (remap == 3) {
                        const int b_ = c >> 11, ch_ = (c >> 6) & 31, s_ = (c >> 5) & 1, fq_ = (c >> 3) & 3, h_ = row >> 8, vs_ = (row >> 5) & 7, n_ = (row >> 4) & 1, fr_ = row & 15;
                        off = ((((size_t)((b_ * 4 + h_) * 8 + vs_) * 32 + ch_) * 4 + n_ * 2 + s_) * 64 + fq_ * 16 + fr_) * 8; }
                    *(u32x4*)(O + off) = w;
                }
        }
    }
};
struct EpiSwiglu {
    bf16_t* O; int ldc; const float* ss;
    __device__ __forceinline__ void operator()(const f32x4 (&acc)[2][2][4][2], const Unit& u, int wr, int wc, int fr, int fq) const {
        const int row0 = u.pm * BM + wr * 64 + fr; const int dc = u.pn * HALF + wc * 32 + 8 * fq;
#pragma unroll
        for (int ai = 0; ai < 2; ++ai)
#pragma unroll
            for (int m = 0; m < 4; ++m) {
                const int row = row0 + ai * HALF + m * 16;
                const float rs = ss ? rsqrtf(ss[row] * (1.f / 2048.f) + EPS) : 1.f;
                const f32x4 g0 = acc[ai][0][m][0] * rs, g1 = acc[ai][0][m][1] * rs, u0 = acc[ai][1][m][0] * rs, u1 = acc[ai][1][m][1] * rs; u32x4 w;
                w.x = pk2(fast_silu(g0[0]) * u0[0], fast_silu(g0[1]) * u0[1]); w.y = pk2(fast_silu(g0[2]) * u0[2], fast_silu(g0[3]) * u0[3]);
                w.z = pk2(fast_silu(g1[0]) * u1[0], fast_silu(g1[1]) * u1[1]); w.w = pk2(fast_silu(g1[2]) * u1[2], fast_silu(g1[3]) * u1[3]);
                *(u32x4*)(O + (size_t)row * ldc + dc) = w;
            }
    }
};
template <int ALPHA2, bool NORM, size_t XBOFF, size_t SSOFF>
struct EpiResid {
    const float* base; float* out; unsigned char* ws;
    __device__ __forceinline__ void operator()(const f32x4 (&acc)[2][2][4][2], const Unit& u, int wr, int wc, int fr, int fq) const {
        const int row0 = u.pm * BM + wr * 64 + fr; constexpr int ldc = 2048; constexpr float alpha = 0.5f * ALPHA2;
        bf16_t* const xb = (bf16_t*)(ws + XBOFF); __attribute__((address_space(1))) float* const ss = (__attribute__((address_space(1))) float*)(ws + SSOFF);
#pragma unroll
        for (int ai = 0; ai < 2; ++ai)
#pragma unroll
            for (int m = 0; m < 4; ++m) {
                const int row = row0 + ai * HALF + m * 16; float sq = 0.f;
#pragma unroll
                for (int bj = 0; bj < 2; ++bj)
#pragma unroll
                    for (int n = 0; n < 2; ++n) {
                        const size_t idx = (size_t)row * ldc + u.pn * BM + bj * HALF + wc * 32 + 8 * fq + 4 * n;
                        const f32x4 b = *(const f32x4*)(base + idx);
                        const f32x4 v = b + acc[ai][bj][m][n] * alpha;
                        *(f32x4*)(out + idx) = v;
                        if (NORM) { u32x2 w; w.x = pk2(v[0], v[1]); w.y = pk2(v[2], v[3]); *(u32x2*)(xb + idx) = w; sq += (v[0] * v[0] + v[1] * v[1]) + (v[2] * v[2] + v[3] * v[3]); }
                    }
                if (NORM) { sq = xor16_sum(sq); sq = xor32_sum(sq); if (fq == 0) __hip_atomic_fetch_add(ss + row, sq, __ATOMIC_RELAXED, __HIP_MEMORY_SCOPE_AGENT); }
            }
    }
};

#ifndef PG8_ALIGN
#define PG8_ALIGN true
#endif
template <class Epi, bool ALIGN_EPI = PG8_ALIGN>
__device__ __forceinline__ void gemm_phase(LAS unsigned char* lds, const Gemm g, const StaticOrder S, const Epi E) {
    const int tid = threadIdx.x, wid = __builtin_amdgcn_readfirstlane(tid >> 6), lane = tid & 63, wr = wid >> 2, wc = wid & 3, fr = lane & 15, fq = lane >> 4;
    const int K = g.K, nt = K / BK;
    unsigned voffA[2], voffB[2];
#pragma unroll
    for (int i = 0; i < 2; ++i) { int R, C; stage_rc(tid * 16 + i * 8192, R, C); const int Rb = (R & ~31) + perm32(R & 31);
        voffA[i] = (unsigned)(R * g.lda + C) * 2u; voffB[i] = (unsigned)(Rb * g.ldb + C) * 2u; }
    const size_t kstep = (size_t)(BK * 2);
    const size_t hstepA = (size_t)HALF * g.lda * 2, hstepB = (size_t)HALF * g.ldb * 2;
    const size_t tstepA = 2 * hstepA, tstepB = 2 * hstepB;
    const unsigned ldsw = (unsigned)wid * 1024u;
    const int aoff = lds_byte(wr * 64 + fr, fq * 8), boff = lds_byte(wc * 32 + fr, fq * 8);
#define PG8_SA(b, h) (((b) * 2 + (h)) * HTB)
#define PG8_SB(b, h) ((4 + (b) * 2 + (h)) * HTB)
#define PG8_STAGE(bufoff, gbase, voff) do { _Pragma("unroll") for (int _i = 0; _i < 2; ++_i) \
        __builtin_amdgcn_global_load_lds((const unsigned*)((const char*)(gbase) + (voff)[_i]), (LAS unsigned*)(lds + (bufoff) + ldsw + _i * 8192), 16, 0, 0); } while (0)
#define PG8_LDA(dst, b, h) do { _Pragma("unroll") for (int m = 0; m < 4; ++m) _Pragma("unroll") for (int k = 0; k < 2; ++k) dst[m][k] = *(const LAS bf16x8*)(lds + PG8_SA(b, h) + aoff + m * 2048 + k * 1024); } while (0)
#define PG8_LDB(dst, b, h) do { _Pragma("unroll") for (int n = 0; n < 2; ++n) _Pragma("unroll") for (int k = 0; k < 2; ++k) dst[n][k] = *(const LAS bf16x8*)(lds + PG8_SB(b, h) + boff + n * 2048 + k * 1024); } while (0)
#define PG8_MMA(ai, bj, At, Bt) do { __builtin_amdgcn_s_setprio(1); _Pragma("unroll") for (int m = 0; m < 4; ++m) _Pragma("unroll") for (int n = 0; n < 2; ++n) _Pragma("unroll") for (int k = 0; k < 2; ++k) \
        acc[ai][bj][m][n] = __builtin_amdgcn_mfma_f32_16x16x32_bf16(Bt[n][k], At[m][k], acc[ai][bj][m][n], 0, 0, 0); __builtin_amdgcn_s_setprio(0); } while (0)
#define PG8_WAIT_V(n) asm volatile("s_waitcnt vmcnt(" #n ")" ::: "memory")
#define PG8_WAIT_L(n) asm volatile("s_waitcnt lgkmcnt(" #n ")" ::: "memory")
#define PG8_BAR __builtin_amdgcn_s_barrier()
#define PG8_SCHED __builtin_amdgcn_sched_barrier(0)
    Unit cur, nxt; int ui = 0;
    if (!S.next(0, cur)) return;
    f32x4 acc[2][2][4][2];
#pragma unroll
    for (int a = 0; a < 2; ++a)
#pragma unroll
        for (int b = 0; b < 2; ++b)
#pragma unroll
            for (int m = 0; m < 4; ++m)
#pragma unroll
                for (int n = 0; n < 2; ++n) acc[a][b][m][n] = (f32x4){0.f, 0.f, 0.f, 0.f};
    bf16x8 At[4][2], B0[2][2], B1[2][2];
    const char* cA = (const char*)g.A + (size_t)cur.pm * tstepA; const char* cB = (const char*)g.Bt + (size_t)cur.pn * tstepB;
    PG8_STAGE(PG8_SB(0, 0), cB, voffB); PG8_STAGE(PG8_SB(0, 1), cB + hstepB, voffB); PG8_STAGE(PG8_SA(0, 0), cA, voffA); PG8_STAGE(PG8_SA(0, 1), cA + hstepA, voffA);
    if (wr == 1) PG8_BAR;
    PG8_WAIT_V(2); PG8_BAR;
    PG8_STAGE(PG8_SB(1, 0), cB + kstep, voffB); PG8_STAGE(PG8_SA(1, 0), cA + kstep, voffA); PG8_STAGE(PG8_SB(1, 1), cB + hstepB + kstep, voffB);
    PG8_WAIT_V(6); PG8_BAR;
    for (;;) {
        const bool has_next = S.next(ui + 1, nxt);
        const char* nA = has_next ? (const char*)g.A + (size_t)nxt.pm * tstepA : cA; const char* nB = has_next ? (const char*)g.Bt + (size_t)nxt.pn * tstepB : cB;
        for (int t = 0; t < nt; t += 2) {
            const bool last = (t == nt - 2);
            const char* a1 = cA + (size_t)(t + 1) * kstep;
            const char* a2 = last ? nA : cA + (size_t)(t + 2) * kstep; const char* b2 = last ? nB : cB + (size_t)(t + 2) * kstep;
            const char* a3 = a2 + kstep; const char* b3 = b2 + kstep;
            PG8_LDB(B0, 0, 0); PG8_LDB(B1, 0, 1); PG8_SCHED; PG8_LDA(At, 0, 0); PG8_STAGE(PG8_SA(1, 1), a1 + hstepA, voffA);
            PG8_WAIT_V(8); PG8_WAIT_L(0); PG8_BAR; PG8_MMA(0, 0, At, B0); PG8_MMA(0, 1, At, B1); PG8_BAR; PG8_SCHED;
            PG8_LDA(At, 0, 1); PG8_STAGE(PG8_SB(0, 0), b2, voffB); PG8_STAGE(PG8_SB(0, 1), b2 + hstepB, voffB); PG8_STAGE(PG8_SA(0, 0), a2, voffA);
            PG8_WAIT_V(8); PG8_WAIT_L(0); PG8_BAR; PG8_MMA(1, 0, At, B0); PG8_MMA(1, 1, At, B1); PG8_BAR; PG8_SCHED;
            PG8_LDB(B0, 1, 0); PG8_LDB(B1, 1, 1); PG8_SCHED; PG8_LDA(At, 1, 0); PG8_STAGE(PG8_SA(0, 1), a2 + hstepA, voffA);
            PG8_WAIT_V(8); PG8_WAIT_L(0); PG8_BAR; PG8_MMA(0, 0, At, B0); PG8_MMA(0, 1, At, B1); PG8_BAR; PG8_SCHED;
            PG8_LDA(At, 1, 1); PG8_STAGE(PG8_SB(1, 0), b3, voffB); PG8_STAGE(PG8_SB(1, 1), b3 + hstepB, voffB); PG8_STAGE(PG8_SA(1, 0), a3, voffA);
            PG8_WAIT_V(8); PG8_WAIT_L(0); PG8_BAR; PG8_MMA(1, 0, At, B0); PG8_MMA(1, 1, At, B1); PG8_BAR; PG8_SCHED;
        }
        if (ALIGN_EPI) { if (wr == 0) PG8_BAR; }
        E(acc, cur, wr, wc, fr, fq);
        if (!has_next) break;
#pragma unroll
        for (int a = 0; a < 2; ++a)
#pragma unroll
            for (int b = 0; b < 2; ++b)
#pragma unroll
                for (int m = 0; m < 4; ++m)
#pragma unroll
                    for (int n = 0; n < 2; ++n) acc[a][b][m][n] = (f32x4){0.f, 0.f, 0.f, 0.f};
        cur = nxt; cA = nA; cB = nB; ++ui;
        if (ALIGN_EPI) { if (wr == 1) PG8_BAR; }
    }
    PG8_WAIT_V(0);
    if (!ALIGN_EPI) { if (wr == 0) PG8_BAR; }
    PG8_BAR;
#undef PG8_SA
#undef PG8_SB
#undef PG8_STAGE
#undef PG8_LDA
#undef PG8_LDB
#undef PG8_MMA
#undef PG8_WAIT_V
#undef PG8_WAIT_L
#undef PG8_BAR
#undef PG8_SCHED
}
}

struct Args {
    const float* in[31];
    float* out;
    unsigned char* ws;
    int ph_lo, ph_hi, rmask, pad;
};

__device__ __forceinline__ int cvt_row(int kind, int n) {
    switch (kind) {
        case 1: return (n >> 7) * 256 + (n & 127);
        case 2: return (n >> 7) * 256 + 128 + (n & 127);
        case 3: return n < 1856 ? n : (n < 2880 ? 3072 + (n - 1856) : n - 1024);
        case 4: { const int h = n >> 8, j = n & 255; return j < 128 ? h * 128 + j : 1024 + h * 128 + (j - 128); }
        case 5: return 512 + n;
        default: return n;
    }
}
struct CvtJob { const float* W; bf16_t* WT; const float* gam; int K, N, kind, item; bool ok; };
__device__ __forceinline__ int cvt_nitems(int K, int N) { return (K / 64) * ((N + 255) / 256); }
__device__ __forceinline__ void cvt_load(const CvtJob& J, f32x4 (&cv)[8], int wave, int lane) {
    const int nblk = (J.N + 255) / 256, kb = J.item / nblk, nb = J.item % nblk, k0 = 64 * kb, n0 = 256 * nb;
    const bool nok = (n0 + 4 * lane) < J.N;
#pragma unroll
    for (int i = 0; i < 8; ++i) { const int k = k0 + wave + 8 * i;
        cv[i] = nok ? *(const f32x4*)(J.W + (size_t)k * J.N + n0 + 4 * lane) : (f32x4){0.f, 0.f, 0.f, 0.f};
        if (J.gam) cv[i] = cv[i] * J.gam[k]; }
}
__device__ __forceinline__ void cvt_to_lds(const f32x4 (&cv)[8], LAS unsigned char* lds, int wave, int lane) {
#pragma unroll
    for (int i = 0; i < 8; ++i) { const int k = wave + 8 * i; *(LAS f32x4*)(lds + (size_t)k * 1024 + (((4 * lane) ^ (4 * (k >> 3))) * 4)) = cv[i]; }
}
__device__ __forceinline__ void cvt_from_lds(const CvtJob& J, LAS unsigned char* lds, int tid) {
    const int nblk = (J.N + 255) / 256, kb = J.item / nblk, nb = J.item % nblk, k0 = 64 * kb, n0 = 256 * nb;
#pragma unroll
    for (int j = 0; j < 4; ++j) {
        const int q = tid + 512 * j, n = q >> 3, c = q & 7;
        const LAS float* sp = (const LAS float*)lds + (8 * c) * 256 + (n ^ (4 * c));
        u32x4 o; o.x = pk2(sp[0 * 256], sp[1 * 256]); o.y = pk2(sp[2 * 256], sp[3 * 256]); o.z = pk2(sp[4 * 256], sp[5 * 256]); o.w = pk2(sp[6 * 256], sp[7 * 256]);
        if (n0 + n < J.N) *(u32x4*)(J.WT + (size_t)cvt_row(J.kind, n0 + n) * J.K + k0 + 8 * c) = o;
    }
}

__device__ __forceinline__ void rms_row2048(const float* xrow, const float* g, bf16_t* orow, int lane) {
    const f32x4* xr = (const f32x4*)xrow + lane; const f32x4* gr = (const f32x4*)g + lane;
    f32x4 v[8]; float s = 0.f;
#pragma unroll
    for (int j = 0; j < 8; ++j) { v[j] = xr[64 * j]; s += (v[j].x * v[j].x + v[j].y * v[j].y) + (v[j].z * v[j].z + v[j].w * v[j].w); }
    const float r = rsqrtf(wave_sum(s) * (1.f / 2048.f) + EPS);
    u32x2* o8 = (u32x2*)orow + lane;
#pragma unroll
    for (int j = 0; j < 8; ++j) { const f32x4 gg = gr[64 * j]; u32x2 w; w.x = pk2(v[j].x * r * gg.x, v[j].y * r * gg.y); w.y = pk2(v[j].z * r * gg.z, v[j].w * r * gg.w); o8[64 * j] = w; }
}

__device__ __forceinline__ void norm_rope192(bf16_t* p0, const bf16_t* p2, bf16_t* d2, const float* g, float cs, float sn, float oscale, int lane) {
    const float a0 = bf2f(p0[lane]), a1 = bf2f(p0[64 + lane]), a2 = bf2f(p2[lane]);
    const float ss = wave_sum(a0 * a0 + a1 * a1 + a2 * a2);
    const float r = rsqrtf(ss * (1.f / 192.f) + EPS);
    const float n0 = a0 * r * g[lane], n1 = a1 * r * g[64 + lane], n2 = a2 * r * g[128 + lane];
    const float pr = lane_xor32(n2, lane);
    const float ro = (lane < 32) ? (n2 * cs - pr * sn) : (n2 * cs + pr * sn);
    p0[lane] = f2bf(n0 * oscale); p0[64 + lane] = f2bf(n1 * oscale); d2[lane] = f2bf(ro * oscale);
}
__device__ __forceinline__ void norm128(bf16_t* p, const float* g, float oscale, int lane) {
    const unsigned u = ((const unsigned*)p)[lane]; const float a0 = bflo(u), a1 = bfhi(u);
    const float ss = wave_sum(a0 * a0 + a1 * a1);
    const float r = rsqrtf(ss * (1.f / 128.f) + EPS) * oscale;
    ((unsigned*)p)[lane] = pk2(a0 * r * g[2 * lane], a1 * r * g[2 * lane + 1]);
}
__device__ __forceinline__ float log_sigmoid(float x) { return fminf(x, 0.f) - __logf(1.f + __expf(-fabsf(x))); }

__device__ __forceinline__ void gla_prep_item(LAS unsigned char* lds, int item, const bf16_t* Z, const float* W2, const float* Bg, bf16_t* KDT, float* DEC) {
    LAS float* zgs = (LAS float*)lds;
    const int tid = threadIdx.x, b = item >> 5, c = item & 31; const size_t row0 = (size_t)b * SEQ + c * 64;
    for (int i = tid; i < 1024; i += 512) { const int t = i >> 4, r = i & 15; zgs[i] = bf2f(Z[(row0 + t) * ZLD + ZZG + r]); }
    __syncthreads();
    const int h = tid >> 7, kd = tid & 127, col = h * 128 + kd;
    float w[16];
#pragma unroll
    for (int r = 0; r < 16; ++r) w[r] = W2[r * 512 + col];
    const float bias = Bg[col];
    float bend = 0.f; float gv[64];
#pragma unroll
    for (int t = 0; t < 64; ++t) {
        float x = bias;
#pragma unroll
        for (int r = 0; r < 16; ++r) x += zgs[t * 16 + r] * w[r];
        gv[t] = log_sigmoid(x) * (1.f / 16.f); bend += gv[t];
    }
    float bc = 0.f;
    bf16_t* dst = KDT + (size_t)((b * 4 + h) * 32 + c) * 8192 + (size_t)((kd >> 4) * 2 * 64 + (kd & 15)) * 8;
    const bf16_t* gk = Z + row0 * ZLD + ZGK + col;
#pragma unroll
    for (int t8 = 0; t8 < 8; ++t8) {
        float kv[8];
#pragma unroll
        for (int e = 0; e < 8; ++e) {
            const int t = t8 * 8 + e;
            bc += gv[t];
            kv[e] = bf2f(gk[(size_t)t * ZLD]) * __expf(bend - bc);
        }
        u32x4 o; o.x = pk2(kv[0], kv[1]); o.y = pk2(kv[2], kv[3]); o.z = pk2(kv[4], kv[5]); o.w = pk2(kv[6], kv[7]);
        *(u32x4*)(dst + ((t8 >> 2) * 64 + (t8 & 3) * 16) * 8) = o;
    }
    DEC[(size_t)((b * 4 + h) * 32 + c) * 128 + kd] = expf(bend);
    __syncthreads();
}

struct GlaSet { bf16x8 a[2], bb[2][2], qa[4]; f32x4 d; };
__device__ __forceinline__ void gla_item(LAS unsigned char* lds, int item, const bf16_t* KDT, const float* DEC, const bf16_t* GVT, const bf16_t* GQF, bf16_t* OG) {
    const int tid = threadIdx.x, wid = __builtin_amdgcn_readfirstlane(tid >> 6), lane = tid & 63, fr = lane & 15, fq = lane >> 4;
    const int vs = item & 7, h = (item >> 3) & 3, b = item >> 5;
    const bf16_t* kdt = KDT + (size_t)((b * 4 + h) * 32) * 8192 + (size_t)(wid * 2 * 64 + lane) * 8;
    const float* dec = DEC + (size_t)((b * 4 + h) * 32) * 128 + 16 * wid + 4 * fq;
    const bf16_t* gvt = GVT + (size_t)item * (32 * 4 * 512) + (size_t)lane * 8;
    const int f0 = 16 * (wid & 3), v0 = 16 * (wid >> 2);
    const bf16_t* gq = GQF + ((size_t)((b * 4 + h) * 32) * 16 + (size_t)(wid & 3) * 4) * 512 + (size_t)lane * 8;
    bf16_t* outp = OG + (size_t)item * (SEQ * 32) + (size_t)(f0 + fr) * 32 + v0 + 4 * fq;
    f32x4 S[2]; S[0] = (f32x4){0.f, 0.f, 0.f, 0.f}; S[1] = S[0];
#define GLA_LOAD(X, c_) do { \
        _Pragma("unroll") for (int s = 0; s < 2; ++s) X.a[s] = *(const bf16x8*)(kdt + (size_t)(c_) * 8192 + s * 512); \
        _Pragma("unroll") for (int n = 0; n < 2; ++n) _Pragma("unroll") for (int s = 0; s < 2; ++s) X.bb[n][s] = *(const bf16x8*)(gvt + (size_t)(c_) * 2048 + (n * 2 + s) * 512); \
        _Pragma("unroll") for (int s = 0; s < 4; ++s) X.qa[s] = *(const bf16x8*)(gq + (size_t)(c_) * (16 * 512) + s * 512); \
        X.d = *(const f32x4*)(dec + (c_) * 128); } while (0)
#define GLA_STEP(X, c_) do { \
        LAS unsigned char* Sb = lds + ((c_) & 1) * (32 * 272); \
        _Pragma("unroll") for (int n = 0; n < 2; ++n) { \
            S[n] = S[n] * X.d; \
            _Pragma("unroll") for (int s = 0; s < 2; ++s) S[n] = __builtin_amdgcn_mfma_f32_16x16x32_bf16(X.a[s], X.bb[n][s], S[n], 0, 0, 0); \
            u32x2 w_; w_.x = pk2(S[n][0], S[n][1]); w_.y = pk2(S[n][2], S[n][3]); \
            *(LAS u32x2*)(Sb + (16 * n + fr) * 272 + (16 * wid + 4 * fq) * 2) = w_; } \
        __syncthreads(); \
        f32x4 o_ = (f32x4){0.f, 0.f, 0.f, 0.f}; \
        _Pragma("unroll") for (int s = 0; s < 4; ++s) { const bf16x8 bf_ = *(const LAS bf16x8*)(Sb + (v0 + fr) * 272 + s * 64 + fq * 16); o_ = __builtin_amdgcn_mfma_f32_16x16x32_bf16(bf_, X.qa[s], o_, 0, 0, 0); } \
        o_ = o_ * 0.08838834764831845f; \
        u32x2 ow_; ow_.x = pk2(o_[0], o_[1]); ow_.y = pk2(o_[2], o_[3]); *(u32x2*)(outp + (size_t)(c_) * 64 * 32) = ow_; } while (0)
    GlaSet s0, s1, s2;
    GLA_LOAD(s0, 0); GLA_LOAD(s1, 1);
#pragma unroll 1
    for (int c = 0; c < 30; c += 3) {
        GLA_LOAD(s2, c + 2); GLA_STEP(s0, c);
        GLA_LOAD(s0, c + 3); GLA_STEP(s1, c + 1);
        GLA_LOAD(s1, c + 4); GLA_STEP(s2, c + 2);
    }
    GLA_STEP(s0, 30); GLA_STEP(s1, 31);
#undef GLA_LOAD
#undef GLA_STEP
    __syncthreads();
}

template <int DQK, int QF>
__device__ __forceinline__ void attn_unit(LAS unsigned char* lds, const bf16_t* Qp, int ldq, const bf16_t* Kp, int ldk, const bf16_t* VTp, int ldvt, bf16_t* Op, int ldo, int nkt, int wave_last, const float* qgam, float qscale) {
    constexpr int KS = DQK / 32, KROW = DQK * 2 + 16, VROW = 144, KBYTES = 64 * KROW, VBYTES = 128 * VROW, BUF = KBYTES + VBYTES;
    constexpr int KCPR = DQK / 8, NKL = (64 * KCPR) / 512;
    const int tid = threadIdx.x, wid = __builtin_amdgcn_readfirstlane(tid >> 6), lane = tid & 63, fr = lane & 15, fq = lane >> 4;
    bf16x8 qreg[QF][KS];
#pragma unroll
    for (int qf = 0; qf < QF; ++qf)
#pragma unroll
        for (int s = 0; s < KS; ++s) qreg[qf][s] = *(const bf16x8*)(Qp + (size_t)(16 * QF * wid + 16 * qf + fr) * ldq + s * 32 + fq * 8);
    if (qgam) {
#pragma unroll
        for (int qf = 0; qf < QF; ++qf) {
            float sq = 0.f;
#pragma unroll
            for (int s = 0; s < KS; ++s)
#pragma unroll
                for (int e = 0; e < 8; ++e) { const float v = bf2f((bf16_t)qreg[qf][s][e]); sq += v * v; }
            sq = xor16_sum(sq); sq = xor32_sum(sq);
            const float r = rsqrtf(sq * (1.f / DQK) + EPS) * qscale;
#pragma unroll
            for (int s = 0; s < KS; ++s) {
                const f32x4 g0 = *(const f32x4*)(qgam + s * 32 + fq * 8), g1 = *(const f32x4*)(qgam + s * 32 + fq * 8 + 4); u32x4 w;
                w.x = pk2(bf2f((bf16_t)qreg[qf][s][0]) * r * g0[0], bf2f((bf16_t)qreg[qf][s][1]) * r * g0[1]); w.y = pk2(bf2f((bf16_t)qreg[qf][s][2]) * r * g0[2], bf2f((bf16_t)qreg[qf][s][3]) * r * g0[3]);
                w.z = pk2(bf2f((bf16_t)qreg[qf][s][4]) * r * g1[0], bf2f((bf16_t)qreg[qf][s][5]) * r * g1[1]); w.w = pk2(bf2f((bf16_t)qreg[qf][s][6]) * r * g1[2], bf2f((bf16_t)qreg[qf][s][7]) * r * g1[3]);
                qreg[qf][s] = __builtin_bit_cast(bf16x8, w);
            }
        }
    }
    f32x4 o[QF][8];
#pragma unroll
    for (int qf = 0; qf < QF; ++qf)
#pragma unroll
        for (int mv = 0; mv < 8; ++mv) o[qf][mv] = (f32x4){0.f, 0.f, 0.f, 0.f};
    float mrun[QF], lrun[QF];
#pragma unroll
    for (int qf = 0; qf < QF; ++qf) { mrun[qf] = -1e30f; lrun[qf] = 0.f; }
    u32x4 kst[NKL], vst[2];
    int kgo[NKL], klo[NKL], vgo[2], vlo[2];
#pragma unroll
    for (int i = 0; i < NKL; ++i) { const int q = tid + 512 * i, row = q / KCPR, cc = q % KCPR; kgo[i] = row * ldk + cc * 8; klo[i] = row * KROW + cc * 16; }
#pragma unroll
    for (int i = 0; i < 2; ++i) { const int q = tid + 512 * i, row = q >> 3, cc = q & 7; vgo[i] = row * ldvt + cc * 8; vlo[i] = KBYTES + row * VROW + cc * 16; }
#define AT_LOAD(t_) do { _Pragma("unroll") for (int i = 0; i < NKL; ++i) kst[i] = *(const u32x4*)(Kp + (size_t)(t_) * 64 * ldk + kgo[i]); \
        _Pragma("unroll") for (int i = 0; i < 2; ++i) vst[i] = *(const u32x4*)(VTp + (size_t)(t_) * 64 + vgo[i]); } while (0)
#define AT_WRITE(buf_) do { _Pragma("unroll") for (int i = 0; i < NKL; ++i) *(LAS u32x4*)(lds + (buf_) * BUF + klo[i]) = kst[i]; \
        _Pragma("unroll") for (int i = 0; i < 2; ++i) *(LAS u32x4*)(lds + (buf_) * BUF + vlo[i]) = vst[i]; } while (0)
    AT_LOAD(0); AT_WRITE(0);
    __syncthreads();
    for (int t = 0; t < nkt; ++t) {
        const bool more = (t + 1 < nkt);
        if (more) AT_LOAD(t + 1);
        if (t <= wave_last) {
            const LAS unsigned char* kb = lds + (t & 1) * BUF; const LAS unsigned char* vb = kb + KBYTES;
            f32x4 st[QF][4];
#pragma unroll
            for (int qf = 0; qf < QF; ++qf)
#pragma unroll
                for (int m = 0; m < 4; ++m) st[qf][m] = (f32x4){0.f, 0.f, 0.f, 0.f};
#pragma unroll
            for (int s = 0; s < KS; ++s)
#pragma unroll
                for (int m = 0; m < 4; ++m) {
                    const bf16x8 kf = *(const LAS bf16x8*)(kb + (16 * m + fr) * KROW + s * 64 + fq * 16);
#pragma unroll
                    for (int qf = 0; qf < QF; ++qf) st[qf][m] = __builtin_amdgcn_mfma_f32_16x16x32_bf16(kf, qreg[qf][s], st[qf][m], 0, 0, 0);
                }
            bf16x8 pb[QF][2];
#pragma unroll
            for (int qf = 0; qf < QF; ++qf) {
                float mx = st[qf][0][0];
#pragma unroll
                for (int m = 0; m < 4; ++m)
#pragma unroll
                    for (int j = 0; j < 4; ++j) mx = fmaxf(mx, st[qf][m][j]);
                mx = xor16_max(mx); mx = xor32_max(mx);
                const float mnew = fmaxf(mrun[qf], mx), alpha = __builtin_amdgcn_exp2f(mrun[qf] - mnew);
                mrun[qf] = mnew;
                float ps = 0.f; float p[4][4];
#pragma unroll
                for (int m = 0; m < 4; ++m)
#pragma unroll
                    for (int j = 0; j < 4; ++j) { p[m][j] = __builtin_amdgcn_exp2f(st[qf][m][j] - mnew); ps += p[m][j]; }
                lrun[qf] = lrun[qf] * alpha + ps;
#pragma unroll
                for (int mv = 0; mv < 8; ++mv) o[qf][mv] = o[qf][mv] * alpha;
#pragma unroll
                for (int s2 = 0; s2 < 2; ++s2) {
                    u32x4 w; w.x = pk2(p[2 * s2][0], p[2 * s2][1]); w.y = pk2(p[2 * s2][2], p[2 * s2][3]); w.z = pk2(p[2 * s2 + 1][0], p[2 * s2 + 1][1]); w.w = pk2(p[2 * s2 + 1][2], p[2 * s2 + 1][3]);
                    pb[qf][s2] = __builtin_bit_cast(bf16x8, w);
                }
            }
#pragma unroll
            for (int s2 = 0; s2 < 2; ++s2)
#pragma unroll
                for (int mv = 0; mv < 8; ++mv) {
                    const LAS unsigned char* vp = vb + (16 * mv + fr) * VROW + (32 * s2 + 4 * fq) * 2;
                    const u32x2 v0 = *(const LAS u32x2*)vp, v1 = *(const LAS u32x2*)(vp + 32);
                    u32x4 vv; vv.x = v0.x; vv.y = v0.y; vv.z = v1.x; vv.w = v1.y;
                    const bf16x8 vf = __builtin_bit_cast(bf16x8, vv);
#pragma unroll
                    for (int qf = 0; qf < QF; ++qf) o[qf][mv] = __builtin_amdgcn_mfma_f32_16x16x32_bf16(vf, pb[qf][s2], o[qf][mv], 0, 0, 0);
                }
        }
        if (more) AT_WRITE((t + 1) & 1);
        __syncthreads();
    }
#undef AT_LOAD
#undef AT_WRITE
#pragma unroll
    for (int qf = 0; qf < QF; ++qf) {
        float l = lrun[qf]; l = xor16_sum(l); l = xor32_sum(l);
        const float inv = 1.f / l;
        bf16_t* op = Op + (size_t)(16 * QF * wid + 16 * qf + fr) * ldo + 4 * fq;
#pragma unroll
        for (int mv = 0; mv < 8; ++mv) { u32x2 w; w.x = pk2(o[qf][mv][0] * inv, o[qf][mv][1] * inv); w.y = pk2(o[qf][mv][2] * inv, o[qf][mv][3] * inv); *(u32x2*)(op + 16 * mv) = w; }
    }
}

template <int DQK, int QF>
__device__ __forceinline__ void attn_unit_dma(LAS unsigned char* lds, const bf16_t* Qp, int ldq, const bf16_t* Kp, int ldk, const bf16_t* VTp, int ldvt, bf16_t* Op, int ldo, int nkt, int wave_last, const float* qgam, float qscale) {
    constexpr int KS = DQK / 32, KROW = DQK * 2 + 16, VROW = 144, KBYTES = 64 * KROW, VBYTES = 128 * VROW, BUF = KBYTES + VBYTES;
    constexpr int KCPR = DQK / 8, NKL = (64 * KCPR) / 512;
    const int tid = threadIdx.x, wid = __builtin_amdgcn_readfirstlane(tid >> 6), lane = tid & 63, fr = lane & 15, fq = lane >> 4;
    bf16x8 qreg[QF][KS];
#pragma unroll
    for (int qf = 0; qf < QF; ++qf)
#pragma unroll
        for (int s = 0; s < KS; ++s) qreg[qf][s] = *(const bf16x8*)(Qp + (size_t)(16 * QF * wid + 16 * qf + fr) * ldq + s * 32 + fq * 8);
    if (qgam) {
#pragma unroll
        for (int qf = 0; qf < QF; ++qf) {
            float sq = 0.f;
#pragma unroll
            for (int s = 0; s < KS; ++s)
#pragma unroll
                for (int e = 0; e < 8; ++e) { const float v = bf2f((bf16_t)qreg[qf][s][e]); sq += v * v; }
            sq = xor16_sum(sq); sq = xor32_sum(sq);
            const float r = rsqrtf(sq * (1.f / DQK) + EPS) * qscale;
#pragma unroll
            for (int s = 0; s < KS; ++s) {
                const f32x4 g0 = *(const f32x4*)(qgam + s * 32 + fq * 8), g1 = *(const f32x4*)(qgam + s * 32 + fq * 8 + 4); u32x4 w;
                w.x = pk2(bf2f((bf16_t)qreg[qf][s][0]) * r * g0[0], bf2f((bf16_t)qreg[qf][s][1]) * r * g0[1]); w.y = pk2(bf2f((bf16_t)qreg[qf][s][2]) * r * g0[2], bf2f((bf16_t)qreg[qf][s][3]) * r * g0[3]);
                w.z = pk2(bf2f((bf16_t)qreg[qf][s][4]) * r * g1[0], bf2f((bf16_t)qreg[qf][s][5]) * r * g1[1]); w.w = pk2(bf2f((bf16_t)qreg[qf][s][6]) * r * g1[2], bf2f((bf16_t)qreg[qf][s][7]) * r * g1[3]);
                qreg[qf][s] = __builtin_bit_cast(bf16x8, w);
            }
        }
    }
    f32x4 o[QF][8];
#pragma unroll
    for (int qf = 0; qf < QF; ++qf)
#pragma unroll
        for (int mv = 0; mv < 8; ++mv) o[qf][mv] = (f32x4){0.f, 0.f, 0.f, 0.f};
    float mrun[QF], lrun[QF];
#pragma unroll
    for (int qf = 0; qf < QF; ++qf) { mrun[qf] = -1e30f; lrun[qf] = 0.f; }
    constexpr int NKI = KBYTES / 1024, NVI = VBYTES / 1024, NIT = NKI + NVI, NJ = (NIT + 7) / 8, KCH = KROW / 16, VCH = VROW / 16;
    static_assert(KBYTES % 1024 == 0 && VBYTES % 1024 == 0, "slot image is whole 1 KiB pieces");
    int goff[NJ];
#pragma unroll
    for (int j = 0; j < NJ; ++j) {
        const int g = wid + 8 * j;
        if (g < NKI) { const int q = g * 64 + lane; int row = q / KCH, cc = q % KCH; if (cc == KCH - 1) cc = KCH - 2; goff[j] = row * ldk + cc * 8; }
        else { const int q = (g - NKI) * 64 + lane; int row = q / VCH, cc = q % VCH; if (cc == VCH - 1) cc = VCH - 2; goff[j] = row * ldvt + cc * 8; }
    }
    const bool full = (wid + 8 * (NJ - 1)) < NIT;
#define AT_DMA(t_, slot_) do { _Pragma("unroll") for (int j = 0; j < NJ; ++j) { const int g = wid + 8 * j; if (g < NIT) { \
        const bf16_t* src_ = (g < NKI) ? (Kp + (size_t)(t_) * 64 * ldk + goff[j]) : (VTp + (size_t)(t_) * 64 + goff[j]); \
        __builtin_amdgcn_global_load_lds((const unsigned*)src_, (LAS unsigned*)(lds + (slot_) * BUF + g * 1024), 16, 0, 0); } } } while (0)
#define AT_WAIT_KEEP1() do { if (full) asm volatile("s_waitcnt vmcnt(%0)" :: "n"(NJ) : "memory"); else asm volatile("s_waitcnt vmcnt(%0)" :: "n"(NJ - 1) : "memory"); } while (0)
#define AT_WAIT_ALL() asm volatile("s_waitcnt vmcnt(0)" ::: "memory")
    asm volatile("s_waitcnt vmcnt(0)" ::: "memory");
    AT_DMA(0, 0);
    if (nkt > 1) { AT_DMA(1, 1); AT_WAIT_KEEP1(); } else AT_WAIT_ALL();
    __builtin_amdgcn_s_barrier();
    int slot = 0;
    for (int t = 0; t < nkt; ++t) {
        const int s2slot = (slot == 0) ? 2 : slot - 1;
        if (t + 2 < nkt) AT_DMA(t + 2, s2slot);
        if (t <= wave_last) {
            const LAS unsigned char* kb = lds + slot * BUF; const LAS unsigned char* vb = kb + KBYTES;
            f32x4 st[QF][4];
#pragma unroll
            for (int qf = 0; qf < QF; ++qf)
#pragma unroll
                for (int m = 0; m < 4; ++m) st[qf][m] = (f32x4){0.f, 0.f, 0.f, 0.f};
            {
                bf16x8 kf[2][4];
#pragma unroll
                for (int m = 0; m < 4; ++m) kf[0][m] = *(const LAS bf16x8*)(kb + (16 * m + fr) * KROW + fq * 16);
#pragma unroll
                for (int s = 0; s < KS; ++s) {
                    if (s + 1 < KS) {
#pragma unroll
                        for (int m = 0; m < 4; ++m) kf[(s + 1) & 1][m] = *(const LAS bf16x8*)(kb + (16 * m + fr) * KROW + (s + 1) * 64 + fq * 16);
                    }
                    __builtin_amdgcn_sched_group_barrier(0x100, 4, 0);
                    __builtin_amdgcn_sched_group_barrier(0x008, 4 * QF, 0);
#pragma unroll
                    for (int m = 0; m < 4; ++m)
#pragma unroll
                        for (int qf = 0; qf < QF; ++qf) st[qf][m] = __builtin_amdgcn_mfma_f32_16x16x32_bf16(kf[s & 1][m], qreg[qf][s], st[qf][m], 0, 0, 0);
                }
            }
            bf16x8 pb[QF][2];
#pragma unroll
            for (int qf = 0; qf < QF; ++qf) {
                float mx = st[qf][0][0];
#pragma unroll
                for (int m = 0; m < 4; ++m)
#pragma unroll
                    for (int j = 0; j < 4; ++j) mx = fmaxf(mx, st[qf][m][j]);
                mx = xor16_max(mx); mx = xor32_max(mx);
                const float mnew = fmaxf(mrun[qf], mx), alpha = __builtin_amdgcn_exp2f(mrun[qf] - mnew);
                mrun[qf] = mnew;
                float ps = 0.f; float p[4][4];
#pragma unroll
                for (int m = 0; m < 4; ++m)
#pragma unroll
                    for (int j = 0; j < 4; ++j) { p[m][j] = __builtin_amdgcn_exp2f(st[qf][m][j] - mnew); ps += p[m][j]; }
                lrun[qf] = lrun[qf] * alpha + ps;
#pragma unroll
                for (int mv = 0; mv < 8; ++mv) o[qf][mv] = o[qf][mv] * alpha;
#pragma unroll
                for (int s2 = 0; s2 < 2; ++s2) {
                    u32x4 w; w.x = pk2(p[2 * s2][0], p[2 * s2][1]); w.y = pk2(p[2 * s2][2], p[2 * s2][3]); w.z = pk2(p[2 * s2 + 1][0], p[2 * s2 + 1][1]); w.w = pk2(p[2 * s2 + 1][2], p[2 * s2 + 1][3]);
                    pb[qf][s2] = __builtin_bit_cast(bf16x8, w);
                }
            }
            {
                u32x2 vr[2][4][2];
#define AT_VLOAD(buf_, grp_) do { _Pragma("unroll") for (int i = 0; i < 4; ++i) { const int s2_ = (grp_) >> 1, mv_ = ((grp_) & 1) * 4 + i; \
                    const LAS unsigned char* vp = vb + (16 * mv_ + fr) * VROW + (32 * s2_ + 4 * fq) * 2; \
                    vr[buf_][i][0] = *(const LAS u32x2*)vp; vr[buf_][i][1] = *(const LAS u32x2*)(vp + 32); } } while (0)
                AT_VLOAD(0, 0);
#pragma unroll
                for (int grp = 0; grp < 4; ++grp) {
                    if (grp + 1 < 4) AT_VLOAD((grp + 1) & 1, grp + 1);
                    __builtin_amdgcn_sched_group_barrier(0x100, 8, 0);
                    __builtin_amdgcn_sched_group_barrier(0x008, 4 * QF, 0);
#pragma unroll
                    for (int i = 0; i < 4; ++i) {
                        const int s2 = grp >> 1, mv = (grp & 1) * 4 + i;
                        u32x4 vv; vv.x = vr[grp & 1][i][0].x; vv.y = vr[grp & 1][i][0].y; vv.z = vr[grp & 1][i][1].x; vv.w = vr[grp & 1][i][1].y;
                        const bf16x8 vf = __builtin_bit_cast(bf16x8, vv);
#pragma unroll
                        for (int qf = 0; qf < QF; ++qf) o[qf][mv] = __builtin_amdgcn_mfma_f32_16x16x32_bf16(vf, pb[qf][s2], o[qf][mv], 0, 0, 0);
                    }
                }
#undef AT_VLOAD
            }
        }
        asm volatile("s_waitcnt lgkmcnt(0)" ::: "memory");
        if (t + 2 < nkt) AT_WAIT_KEEP1(); else AT_WAIT_ALL();
        __builtin_amdgcn_s_barrier();
        slot = (slot == 2) ? 0 : slot + 1;
    }
#undef AT_DMA
#undef AT_WAIT_KEEP1
#undef AT_WAIT_ALL
#pragma unroll
    for (int qf = 0; qf < QF; ++qf) {
        float l = lrun[qf]; l = xor16_sum(l); l = xor32_sum(l);
        const float inv = 1.f / l;
        bf16_t* op = Op + (size_t)(16 * QF * wid + 16 * qf + fr) * ldo + 4 * fq;
#pragma unroll
        for (int mv = 0; mv < 8; ++mv) { u32x2 w; w.x = pk2(o[qf][mv][0] * inv, o[qf][mv][1] * inv); w.y = pk2(o[qf][mv][2] * inv, o[qf][mv][3] * inv); *(u32x2*)(op + 16 * mv) = w; }
    }
}

#define XB_TMO      128
#define XB_XCNT(j)  (256  + 64 * (j))
#define XB_XSUB(j)  (1280 + 64 * (j))
#define XB_XGEN(j)  (2304 + 64 * (j))
#define XB_TOP      3328
#define XB_TOPGEN   3392
#define XCD_BAR_WORDS 3456
#define XB_SPIN_CAP (1u << 18)

__device__ __forceinline__ unsigned xb_ld(unsigned* p)              { return __hip_atomic_load(p, __ATOMIC_RELAXED, __HIP_MEMORY_SCOPE_AGENT); }
__device__ __forceinline__ unsigned xb_add(unsigned* p, unsigned v) { return __hip_atomic_fetch_add(p, v, __ATOMIC_RELAXED, __HIP_MEMORY_SCOPE_AGENT); }
__device__ __forceinline__ unsigned xb_xcc_id() { return (unsigned)__builtin_amdgcn_s_getreg((3 << 11) | 20) & 0xFu; }
#define XB_SPIN(cond, bar) do { unsigned _sp = 0; while (cond) { __builtin_amdgcn_s_sleep(1); \
    if ((++_sp & 255u) == 0u) { if (xb_ld(&(bar)[XB_TMO])) break; if (_sp > XB_SPIN_CAP) { atomicAdd(&(bar)[XB_TMO], 1u); break; } } } } while (0)

struct XcdBarrier {
    unsigned* bar; unsigned x;
    volatile LAS unsigned* st;
};

__device__ __forceinline__ XcdBarrier xcd_barrier_post(unsigned* bar, volatile LAS unsigned* st) {
    XcdBarrier b; b.bar = bar; b.x = xb_xcc_id(); b.st = st;
    if (threadIdx.x == 0) (void)xb_add(&bar[XB_XCNT(b.x)], 1u);
    return b;
}
__device__ __forceinline__ void xcd_barrier_complete(unsigned* bar, unsigned x, unsigned& nloc, unsigned& nx) {
    const unsigned G = gridDim.x * gridDim.y * gridDim.z;
    unsigned sum, cnt, mine, sp = 0u;
    for (;;) {
        sum = 0u; cnt = 0u; mine = 0u;
#pragma unroll
        for (unsigned j = 0; j < 16; ++j) { const unsigned c = xb_ld(&bar[XB_XCNT(j)]); sum += c; cnt += (c > 0u) ? 1u : 0u; mine = (j == x) ? c : mine; }
        if (sum == G) break;
        __builtin_amdgcn_s_sleep(1);
        if ((++sp & 255u) == 0u) { if (xb_ld(&bar[XB_TMO])) break; if (sp > XB_SPIN_CAP) { atomicAdd(&bar[XB_TMO], 1u); break; } }
    }
    nloc = mine > 0u ? mine : 1u; nx = cnt > 0u ? cnt : 1u;
}

__device__ __forceinline__ void xcd_barrier(const XcdBarrier& b) {
    asm volatile("s_waitcnt vmcnt(0)" ::: "memory");
    __syncthreads();
    if (threadIdx.x == 0) {
        unsigned* bar = b.bar;
        __builtin_amdgcn_s_waitcnt(0);
        unsigned nloc = b.st[0], nx = b.st[1];
        if (nloc == 0u) { xcd_barrier_complete(bar, b.x, nloc, nx); b.st[0] = nloc; b.st[1] = nx; }
        const unsigned old = xb_add(&bar[XB_XSUB(b.x)], 1u);
        const unsigned gen = old / nloc;
        if (old + 1u == (gen + 1u) * nloc) {
            __builtin_amdgcn_fence(__ATOMIC_RELEASE, "agent");
            asm volatile("s_waitcnt vmcnt(0)" ::: "memory");
            const unsigned og = xb_add(&bar[XB_TOP], 1u);
            const unsigned tg = og / nx;
            if (og + 1u == (tg + 1u) * nx) xb_add(&bar[XB_TOPGEN], 1u);
            else XB_SPIN(xb_ld(&bar[XB_TOPGEN]) == tg, bar);
            __builtin_amdgcn_fence(__ATOMIC_ACQUIRE, "agent");
            xb_add(&bar[XB_XGEN(b.x)], 1u);
            asm volatile("s_waitcnt vmcnt(0)" ::: "memory");
        } else {
            XB_SPIN(xb_ld(&bar[XB_XGEN(b.x)]) == gen, bar);
            __builtin_amdgcn_fence(__ATOMIC_ACQUIRE, "agent");
            asm volatile("s_waitcnt vmcnt(0)" ::: "memory");
        }
    }
    __syncthreads();
}


__device__ __forceinline__ void grid_barrier(unsigned* bar, unsigned epoch, unsigned G) {
    asm volatile("s_waitcnt vmcnt(0)" ::: "memory");
    __syncthreads();
    if (threadIdx.x == 0) {
        __builtin_amdgcn_fence(__ATOMIC_RELEASE, "agent");
        asm volatile("s_waitcnt vmcnt(0)" ::: "memory");
        __hip_atomic_fetch_add(bar + 32 * (blockIdx.x & 7), 1u, __ATOMIC_RELAXED, __HIP_MEMORY_SCOPE_AGENT);
        const unsigned base = G >> 3, rem = G & 7;
        for (;;) {
            unsigned c[8]; bool ok = true;
#pragma unroll
            for (int i = 0; i < 8; ++i) c[i] = __hip_atomic_load(bar + 32 * i, __ATOMIC_RELAXED, __HIP_MEMORY_SCOPE_AGENT);
#pragma unroll
            for (int i = 0; i < 8; ++i) ok = ok && (c[i] >= epoch * (base + ((unsigned)i < rem ? 1u : 0u)));
            if (ok) break;
            __builtin_amdgcn_s_sleep(1);
        }
        __builtin_amdgcn_fence(__ATOMIC_ACQUIRE, "agent");
        asm volatile("s_waitcnt vmcnt(0)" ::: "memory");
    }
    __syncthreads();
}

__global__ void __launch_bounds__(512, 2) mega_fwd(Args args) {
    extern __shared__ __attribute__((aligned(16))) unsigned char lds_raw[];
    LAS unsigned char* lds = (LAS unsigned char*)lds_raw;
    const int tid = threadIdx.x, lane = tid & 63, wave = __builtin_amdgcn_readfirstlane(tid >> 6);
    const int G = gridDim.x, cu = blockIdx.x;
    const int gw = cu * 8 + wave, NGW = G * 8;
    unsigned char* ws = args.ws;
    const float* x = args.in[0]; const float* mem = args.in[1]; const int* positions = (const int*)args.in[2];
    float* out = args.out;
    bf16_t* WGU = (bf16_t*)(ws + WS_WGU); bf16_t* WD = (bf16_t*)(ws + WS_WD); bf16_t* WIN = (bf16_t*)(ws + WS_WIN); bf16_t* WOUT = (bf16_t*)(ws + WS_WOUT);
    bf16_t* WMKV = (bf16_t*)(ws + WS_WMKV); bf16_t* WMQ = (bf16_t*)(ws + WS_WMQ); bf16_t* WMO = (bf16_t*)(ws + WS_WMO); bf16_t* WQUP = (bf16_t*)(ws + WS_WQUP); bf16_t* WKVUP = (bf16_t*)(ws + WS_WKVUP);
    bf16_t* H = (bf16_t*)(ws + WS_H); bf16_t* CAT = H; bf16_t* ACT = (bf16_t*)(ws + WS_ACT);
    bf16_t* Z = (bf16_t*)(ws + WS_Z); bf16_t* GVT = (bf16_t*)(ws + WS_GVT); bf16_t* QA = (bf16_t*)(ws + WS_QA); bf16_t* KVA = (bf16_t*)(ws + WS_KVA);
    bf16_t* KDT = (bf16_t*)(ws + WS_KDT); float* DEC = (float*)(ws + WS_DEC); bf16_t* MK = (bf16_t*)(ws + WS_MK); bf16_t* MVT = (bf16_t*)(ws + WS_MVT);
    bf16_t* Qb = (bf16_t*)(ws + WS_Q); bf16_t* Kb = (bf16_t*)(ws + WS_K); bf16_t* VT = (bf16_t*)(ws + WS_VT); bf16_t* MEMN = (bf16_t*)(ws + WS_MEMN);
    bf16_t* MQ = (bf16_t*)(ws + WS_MQ); bf16_t* OMEM = (bf16_t*)(ws + WS_OMEM); bf16_t* OG = (bf16_t*)(ws + WS_OG);
    LAS float* scr = (LAS float*)(lds + wave * 16384);

    const int lo = args.ph_lo, hi = args.ph_hi;
#ifndef PH_MASK
#define PH_MASK 0x3ffff
#endif
#define IN(k) (((PH_MASK >> (k)) & 1) && lo <= (k) && (k) < hi)
    unsigned* const gbar = (unsigned*)(ws + WS_BAR); unsigned epoch = 0;
    volatile LAS unsigned* xst = (volatile LAS unsigned*)(lds + 132608);
    if (tid < 4) xst[tid] = 0u;
    __syncthreads();
    const XcdBarrier xbar = xcd_barrier_post(gbar, xst);
#define SEAM(k) do { if (IN(k) && IN((k) + 1)) { xcd_barrier(xbar); } } while (0)
#define CVT_DEC(J, W_, K_, N_, DST_, KIND_, GAM_) if (!J.ok) { const int ni = cvt_nitems(K_, N_); if (r < ni) { J.W = W_; J.WT = DST_; J.gam = GAM_; J.K = K_; J.N = N_; J.kind = KIND_; J.item = r; J.ok = true; } else r -= ni; }
    float* SS1 = (float*)(ws + WS_SS); float* SS2 = SS1 + T; float* SS3 = SS2 + T; bf16_t* XB2 = (bf16_t*)(ws + WS_XB2);
    const float* nogam = nullptr;

    if (args.pad == 0x7fffffff) cg::this_grid().sync();
    if (IN(0)) {
#define CVT_DECODE_P0(J, it_) do { int r = (it_); J.ok = false; \
            CVT_DEC(J, args.in[4], D, FF, WGU, 1, nogam) CVT_DEC(J, args.in[5], D, FF, WGU, 2, nogam) CVT_DEC(J, args.in[6], FF, D, WD, 0, nogam) \
            CVT_DEC(J, args.in[8], D, 3920, WIN, 3, args.in[7]) CVT_DEC(J, args.in[10], 512, 1536, WQUP, 0, nogam) CVT_DEC(J, args.in[12], 256, 2048, WKVUP, 4, nogam) \
            CVT_DEC(J, args.in[18], D, D, WOUT, 0, nogam) CVT_DEC(J, args.in[21], D, 512, WMQ, 0, args.in[19]) CVT_DEC(J, args.in[22], D, 512, WMKV, 0, nogam) \
            CVT_DEC(J, args.in[23], D, 512, WMKV, 5, nogam) CVT_DEC(J, args.in[24], 512, D, WMO, 0, nogam) } while (0)
        {
            CvtJob cur, nxt; f32x4 cv[8]; int it = cu;
            CVT_DECODE_P0(cur, it); if (cur.ok) cvt_load(cur, cv, wave, lane);
            while (cur.ok) {
                cvt_to_lds(cv, lds, wave, lane);
                __syncthreads();
                it += G; CVT_DECODE_P0(nxt, it); if (nxt.ok) cvt_load(nxt, cv, wave, lane);
                cvt_from_lds(cur, lds, tid);
                __syncthreads();
                cur = nxt;
            }
        }
        {
            u32x4* zp = (u32x4*)(WIN + (size_t)ZUSED * D); const int nz = (ZLD - ZUSED) * D * 2 / 16;
            for (int i = cu * 512 + tid; i < nz; i += G * 512) zp[i] = (u32x4){0u, 0u, 0u, 0u};
            for (int i = cu * 512 + tid; i < 3 * T; i += G * 512) SS1[i] = 0.f;
        }
        {
            f32x4 nv[8], gg8[8];
#pragma unroll
            for (int j = 0; j < 8; ++j) gg8[j] = ((const f32x4*)args.in[3] + lane)[64 * j];
#define RMS_LOAD(m_) do { _Pragma("unroll") for (int j = 0; j < 8; ++j) nv[j] = ((const f32x4*)(x + (size_t)(m_) * D) + lane)[64 * j]; } while (0)
            if (gw < T) RMS_LOAD(gw);
            for (int m = gw; m < T; m += NGW) {
                f32x4 v[8]; float sq = 0.f;
#pragma unroll
                for (int j = 0; j < 8; ++j) { v[j] = nv[j]; sq += (v[j].x * v[j].x + v[j].y * v[j].y) + (v[j].z * v[j].z + v[j].w * v[j].w); }
                if (m + NGW < T) RMS_LOAD(m + NGW);
                const float r = rsqrtf(wave_sum(sq) * (1.f / 2048.f) + EPS);
                u32x2* o8 = (u32x2*)(H + (size_t)m * D) + lane;
#pragma unroll
                for (int j = 0; j < 8; ++j) { u32x2 w; w.x = pk2(v[j].x * r * gg8[j].x, v[j].y * r * gg8[j].y); w.y = pk2(v[j].z * r * gg8[j].z, v[j].w * r * gg8[j].w); o8[64 * j] = w; }
            }
#undef RMS_LOAD
        }
    }
    SEAM(0);
#ifndef EXTRA_SYNCS
#define EXTRA_SYNCS 0
#endif
#pragma unroll 1
    for (int es = 0; es < EXTRA_SYNCS + args.ph_lo; ++es) grid_barrier(gbar, ++epoch, (unsigned)G);
    if (IN(1)) {
        pg8::Gemm g{H, WGU, D, D, D}; pg8::StaticOrder S; S.init(T, 2 * FF, G, cu);
        pg8::EpiSwiglu E{ACT, FF, nullptr};
        pg8::gemm_phase(lds, g, S, E);
    }
    SEAM(1);
    if (IN(2)) {
        pg8::Gemm g{ACT, WD, FF, FF, FF}; pg8::StaticOrder S; S.init(T, D, G, cu);
        pg8::EpiResid<1, true, WS_H, WS_SS> E{x, out, ws};
        pg8::gemm_phase(lds, g, S, E);
    }
    SEAM(2);
    if (IN(3)) {
        { pg8::Gemm g{H, WIN, D, D, D}; pg8::StaticOrder S; S.init(T, ZLD, G, cu); pg8::EpiStore E{Z, ZLD, 0, SS1, 1}; pg8::gemm_phase(lds, g, S, E); }
        { pg8::Gemm g{WIN + (size_t)ZLD * D, H, D, D, D}; pg8::StaticOrder S; S.init(1024, T, G, cu); pg8::EpiStore E{GVT, T, 3, SS1, 2}; pg8::gemm_phase(lds, g, S, E); }
    }
    SEAM(3);
    if (IN(4)) {
#ifndef DUP_GLAPREP
#define DUP_GLAPREP 0
#endif
#pragma unroll 1
        for (int rep = 0; rep < args.ph_lo + 1 + DUP_GLAPREP; ++rep)
        for (int it = cu; it < NB * 32; it += G) gla_prep_item(lds, it, Z, args.in[15], args.in[16], KDT, DEC);
        u32x4 nzq, ngq; u32x2 nzkv;
#define P4_LOAD(m_) do { const bf16_t* zr_ = Z + (size_t)(m_) * ZLD; nzq = *(const u32x4*)(zr_ + ZQ + lane * 8); nzkv = *(const u32x2*)(zr_ + ZKV + lane * 4); \
            ngq = *(const u32x4*)(zr_ + ZGQ + (lane >> 4) * 128 + (lane & 15) * 8); } while (0)
        if (gw < T) P4_LOAD(gw);
        for (int m = gw; m < T; m += NGW) {
            const u32x4 czq = nzq, cgq = ngq; const u32x2 czkv = nzkv;
            if (m + NGW < T) P4_LOAD(m + NGW);
            {
                const int h_ = lane >> 4, pc = lane & 15, fr_ = m & 15, fw_ = (m >> 4) & 3, ch_ = (m >> 6) & 31, b_ = m >> 11;
                const u32x4 gqv = cgq;
                *(u32x4*)(H + ((((size_t)((b_ * 4 + h_) * 32 + ch_) * 4 + fw_) * 4 + (pc >> 2)) * 64 + (pc & 3) * 16 + fr_) * 8) = gqv;
            }
            {
                const u32x4 u = czq;
                float v[8] = {bflo(u.x), bfhi(u.x), bflo(u.y), bfhi(u.y), bflo(u.z), bfhi(u.z), bflo(u.w), bfhi(u.w)};
                float sq = 0.f;
#pragma unroll
                for (int e = 0; e < 8; ++e) sq += v[e] * v[e];
                const float r = rsqrtf(wave_sum(sq) * (1.f / 512.f) + EPS);
                const f32x4 g0 = *(const f32x4*)(args.in[9] + lane * 8), g1 = *(const f32x4*)(args.in[9] + lane * 8 + 4);
                u32x4 w; w.x = pk2(v[0] * r * g0.x, v[1] * r * g0.y); w.y = pk2(v[2] * r * g0.z, v[3] * r * g0.w); w.z = pk2(v[4] * r * g1.x, v[5] * r * g1.y); w.w = pk2(v[6] * r * g1.z, v[7] * r * g1.w);
                *(u32x4*)(QA + (size_t)m * 512 + lane * 8) = w;
            }
            {
                const u32x2 u = czkv;
                const float v0 = bflo(u.x), v1 = bfhi(u.x), v2 = bflo(u.y), v3 = bfhi(u.y);
                const float r = rsqrtf(wave_sum(v0 * v0 + v1 * v1 + v2 * v2 + v3 * v3) * (1.f / 256.f) + EPS);
                const f32x4 g0 = *(const f32x4*)(args.in[11] + lane * 4);
                u32x2 w; w.x = pk2(v0 * r * g0.x, v1 * r * g0.y); w.y = pk2(v2 * r * g0.z, v3 * r * g0.w);
                *(u32x2*)(KVA + (size_t)m * 256 + lane * 4) = w;
            }
        }
        for (int m = gw; m < NB * 256; m += NGW) rms_row2048(mem + (size_t)m * D, args.in[20], MEMN + (size_t)m * D, lane);
#define CVT_DECODE_P4(J, it_) do { int r = (it_); J.ok = false; \
            CVT_DEC(J, args.in[28], D, FF, WGU, 1, args.in[27]) CVT_DEC(J, args.in[29], D, FF, WGU, 2, args.in[27]) CVT_DEC(J, args.in[30], FF, D, WD, 0, nogam) } while (0)
#ifndef DUP_CVT4
#define DUP_CVT4 0
#endif
#pragma unroll 1
        for (int rep = 0; rep < args.ph_lo + 1 + DUP_CVT4; ++rep)
        {
            CvtJob cur, nxt; f32x4 cv[8]; int it = cu;
            CVT_DECODE_P4(cur, it); if (cur.ok) cvt_load(cur, cv, wave, lane);
            while (cur.ok) {
                cvt_to_lds(cv, lds, wave, lane);
                __syncthreads();
                it += G; CVT_DECODE_P4(nxt, it); if (nxt.ok) cvt_load(nxt, cv, wave, lane);
                cvt_from_lds(cur, lds, tid);
                __syncthreads();
                cur = nxt;
            }
        }
    }
    SEAM(4);
    if (IN(5)) {
        { pg8::Gemm g{QA, WQUP, 512, 512, 512}; pg8::StaticOrder S; S.init(T, 1536, G, cu); pg8::EpiStore E{Qb, 1536, 0, nullptr, 0}; pg8::gemm_phase(lds, g, S, E); }
        { pg8::Gemm g{KVA, WKVUP, 256, 256, 256}; pg8::StaticOrder S; if ((G & 15) == 0) S.init(T, 1024, G / 2, cu >= G / 2 ? cu - G / 2 : (1 << 20)); else S.init(T, 1024, G, cu); pg8::EpiStore E{Kb, 1536, 1, nullptr, 0}; pg8::gemm_phase(lds, g, S, E); }
        { pg8::Gemm g{WKVUP + (size_t)1024 * 256, KVA, 256, 256, 256}; pg8::StaticOrder S; S.init(1024, T, G, cu); pg8::EpiStore E{VT, T, 0, nullptr, 0}; pg8::gemm_phase(lds, g, S, E); }
    }
    SEAM(5);
    if (IN(6)) {
#ifndef DUP_GLA
#define DUP_GLA 0
#endif
#pragma unroll 1
        for (int rep = 0; rep < args.ph_lo + 1 + DUP_GLA; ++rep)
        for (int it = cu; it < 256; it += G) gla_item(lds, ((it & 7) * 4 + (it >> 6)) * 8 + ((it >> 3) & 7), KDT, DEC, GVT, H, OG);
#ifndef DUP_MLAPREP
#define DUP_MLAPREP 0
#endif
#pragma unroll 1
        for (int rep = 0; rep < args.ph_lo + 1 + DUP_MLAPREP; ++rep)
        {
            const int hh = lane >> 3, jj = lane & 7;
            const float* gqn = args.in[13]; const float* gkn = args.in[14];
            f32x4 gq[4], gk[4];
#pragma unroll
            for (int i = 0; i < 4; ++i) { gq[i] = *(const f32x4*)(gqn + 16 * jj + 4 * i); gk[i] = *(const f32x4*)(gkn + 16 * jj + 4 * i); }
            const f32x4 gq1 = *(const f32x4*)(gqn + 128 + 4 * jj), gq2 = *(const f32x4*)(gqn + 160 + 4 * jj), gk1 = *(const f32x4*)(gkn + 128 + 4 * jj), gk2 = *(const f32x4*)(gkn + 160 + 4 * jj);
            float ifr[4];
#pragma unroll
            for (int e = 0; e < 4; ++e) ifr[e] = exp2f(-(float)(4 * jj + e) * (13.287712379549449f / 32.f));
            const float qsc = 0.07216878364870322f * LOG2E;
            u32x4 nqa0, nqa1, nka0, nka1; u32x2 nqr1, nqr2, nkr1, nkr2; int npos;
#define MLAP_LOAD(m_) do { const bf16_t* qp_ = Qb + (size_t)(m_) * 1536 + hh * 192; const bf16_t* kp_ = Kb + (size_t)(m_) * 1536 + hh * 192; const bf16_t* zk_ = Z + (size_t)(m_) * ZLD + ZKR; \
                nqa0 = *(const u32x4*)(qp_ + 16 * jj); nqa1 = *(const u32x4*)(qp_ + 16 * jj + 8); nqr1 = *(const u32x2*)(qp_ + 128 + 4 * jj); nqr2 = *(const u32x2*)(qp_ + 160 + 4 * jj); \
                nka0 = *(const u32x4*)(kp_ + 16 * jj); nka1 = *(const u32x4*)(kp_ + 16 * jj + 8); nkr1 = *(const u32x2*)(zk_ + 4 * jj); nkr2 = *(const u32x2*)(zk_ + 32 + 4 * jj); npos = positions[m_]; } while (0)
            if (gw < T) MLAP_LOAD(gw);
            for (int m = gw; m < T; m += NGW) {
                bf16_t* qp = Qb + (size_t)m * 1536 + hh * 192; bf16_t* kp = Kb + (size_t)m * 1536 + hh * 192;
                const u32x4 qa0 = nqa0, qa1 = nqa1, ka0 = nka0, ka1 = nka1; const u32x2 qr1 = nqr1, qr2 = nqr2, kr1 = nkr1, kr2 = nkr2;
                const float pos = (float)npos;
                if (m + NGW < T) MLAP_LOAD(m + NGW);
                float cs[4], sn[4];
#pragma unroll
                for (int e = 0; e < 4; ++e) { const float ang = pos * ifr[e]; double rv = (double)ang * 0.15915494309189535; rv -= rint(rv); const float rf = (float)rv; cs[e] = __builtin_amdgcn_cosf(rf); sn[e] = __builtin_amdgcn_sinf(rf); }
#define MLAP_ONE(A0, A1, R1, R2, G, G1, G2, SC, DST) do { \
                    float v[16]; \
                    v[0] = bflo(A0.x); v[1] = bfhi(A0.x); v[2] = bflo(A0.y); v[3] = bfhi(A0.y); v[4] = bflo(A0.z); v[5] = bfhi(A0.z); v[6] = bflo(A0.w); v[7] = bfhi(A0.w); \
                    v[8] = bflo(A1.x); v[9] = bfhi(A1.x); v[10] = bflo(A1.y); v[11] = bfhi(A1.y); v[12] = bflo(A1.z); v[13] = bfhi(A1.z); v[14] = bflo(A1.w); v[15] = bfhi(A1.w); \
                    float x1[4] = {bflo(R1.x), bfhi(R1.x), bflo(R1.y), bfhi(R1.y)}, x2[4] = {bflo(R2.x), bfhi(R2.x), bflo(R2.y), bfhi(R2.y)}; \
                    float sq = 0.f; \
                    _Pragma("unroll") for (int i = 0; i < 16; ++i) sq += v[i] * v[i]; \
                    _Pragma("unroll") for (int e = 0; e < 4; ++e) sq += x1[e] * x1[e] + x2[e] * x2[e]; \
                    sq += dpp_mov<0xB1>(sq); sq += dpp_mov<0x4E>(sq); sq += dpp_mov<0x141>(sq); \
                    const float r = rsqrtf(sq * (1.f / 192.f) + EPS) * (SC); \
                    u32x4 w0, w1; \
                    w0.x = pk2(v[0] * r * G[0][0], v[1] * r * G[0][1]); w0.y = pk2(v[2] * r * G[0][2], v[3] * r * G[0][3]); w0.z = pk2(v[4] * r * G[1][0], v[5] * r * G[1][1]); w0.w = pk2(v[6] * r * G[1][2], v[7] * r * G[1][3]); \
                    w1.x = pk2(v[8] * r * G[2][0], v[9] * r * G[2][1]); w1.y = pk2(v[10] * r * G[2][2], v[11] * r * G[2][3]); w1.z = pk2(v[12] * r * G[3][0], v[13] * r * G[3][1]); w1.w = pk2(v[14] * r * G[3][2], v[15] * r * G[3][3]); \
                    float y1[4], y2[4]; \
                    _Pragma("unroll") for (int e = 0; e < 4; ++e) { const float a = x1[e] * r * G1[e], bq = x2[e] * r * G2[e]; y1[e] = a * cs[e] - bq * sn[e]; y2[e] = bq * cs[e] + a * sn[e]; } \
                    u32x2 o1, o2; o1.x = pk2(y1[0], y1[1]); o1.y = pk2(y1[2], y1[3]); o2.x = pk2(y2[0], y2[1]); o2.y = pk2(y2[2], y2[3]); \
                    *(u32x4*)(DST + 16 * jj) = w0; *(u32x4*)(DST + 16 * jj + 8) = w1; *(u32x2*)(DST + 128 + 4 * jj) = o1; *(u32x2*)(DST + 160 + 4 * jj) = o2; } while (0)
                MLAP_ONE(qa0, qa1, qr1, qr2, gq, gq1, gq2, qsc, qp);
                MLAP_ONE(ka0, ka1, kr1, kr2, gk, gk1, gk2, 1.f, kp);
#undef MLAP_ONE
#undef MLAP_LOAD
            }
        }
    }
    SEAM(6);
    if (IN(7)) {
        {
            const f32x4 gg = *(const f32x4*)(args.in[17] + lane * 4);
            u32x2 nu[4], nzu[4];
#define GLAP_LOAD(m_) do { _Pragma("unroll") for (int h = 0; h < 4; ++h) { \
                    nu[h] = *(const u32x2*)(OG + (size_t)((((m_) >> 11) * 4 + h) * 8 + (lane >> 3)) * (SEQ * 32) + (size_t)((m_) & 2047) * 32 + (lane & 7) * 4); \
                    nzu[h] = *(const u32x2*)(Z + (size_t)(m_) * ZLD + ZZR + h * 256 + lane * 4); } } while (0)
            if (gw < T) GLAP_LOAD(gw);
            for (int m = gw; m < T; m += NGW) {
                u32x2 u[4], zu[4];
#pragma unroll
                for (int h = 0; h < 4; ++h) { u[h] = nu[h]; zu[h] = nzu[h]; }
                if (m + NGW < T) GLAP_LOAD(m + NGW);
#pragma unroll
                for (int h = 0; h < 4; ++h) {
                    const float v0 = bflo(u[h].x), v1 = bfhi(u[h].x), v2 = bflo(u[h].y), v3 = bfhi(u[h].y);
                    const float r = rsqrtf(wave_sum(v0 * v0 + v1 * v1 + v2 * v2 + v3 * v3) * (1.f / 256.f) + EPS);
                    const float z0 = bflo(zu[h].x), z1 = bfhi(zu[h].x), z2 = bflo(zu[h].y), z3 = bfhi(zu[h].y);
                    u32x2 w; w.x = pk2(v0 * r * gg.x * fast_silu(z0), v1 * r * gg.y * fast_silu(z1));
                    w.y = pk2(v2 * r * gg.z * fast_silu(z2), v3 * r * gg.w * fast_silu(z3));
                    *(u32x2*)(CAT + (size_t)m * 2048 + 1024 + h * 256 + lane * 4) = w;
                }
            }
        }
        __syncthreads();
#ifndef MLA_QF
#define MLA_QF 2
#endif
        constexpr int QR = 128 * MLA_QF, NQB = SEQ / QR, NPAIR = NB * 8 * NQB / 2;
#ifndef DUP_ATT
#define DUP_ATT 0
#endif
#pragma unroll 1
        for (int rep = 0; rep < args.ph_lo + 1 + DUP_ATT; ++rep)
        for (int p = cu; p < NPAIR; p += G) {
            const int xcd_ = p & 7, idx_ = p >> 3, bh = (NPAIR % 8 == 0) ? xcd_ * (NPAIR / 8 / (NQB / 2)) + idx_ / (NQB / 2) : p / (NQB / 2), qp = (NPAIR % 8 == 0) ? idx_ % (NQB / 2) : p % (NQB / 2), b = bh >> 3, h = bh & 7;
#pragma unroll 1
            for (int half = 0; half < 2; ++half) {
                const int qb = half ? NQB - 1 - qp : qp;
                const size_t r0 = (size_t)b * SEQ + qb * QR;
                attn_unit_dma<192, MLA_QF>(lds, Qb + r0 * 1536 + h * 192, 1536, Kb + (size_t)b * SEQ * 1536 + h * 192, 1536, VT + (size_t)(h * 128) * T + (size_t)b * SEQ, T,
                               CAT + r0 * 2048 + h * 128, 2048, (QR / 64) * (qb + 1), (qb * QR + 16 * MLA_QF * wave) / 64, nullptr, 1.f);
            }
        }
    }
    SEAM(7);
    if (IN(8)) {
        pg8::Gemm g{CAT, WOUT, D, D, D}; pg8::StaticOrder S; S.init(T, D, G, cu);
        pg8::EpiResid<2, true, WS_XB2, WS_SS + (size_t)T * 4> E{out, out, ws};
        pg8::gemm_phase(lds, g, S, E);
    }
    SEAM(8);
    if (IN(9)) {
        { pg8::Gemm g{XB2, WMQ, D, D, D}; pg8::StaticOrder S; S.init(T, 512, G, cu); pg8::EpiStore E{MQ, 512, 0, SS2, 1}; pg8::gemm_phase(lds, g, S, E); }
        { pg8::Gemm g{MEMN, WMKV, D, D, D}; pg8::StaticOrder S; S.init(NB * 256, 512, G, (cu + 128) % G); pg8::EpiStore E{MK, 512, 0, nullptr, 0}; pg8::gemm_phase(lds, g, S, E); }
        { pg8::Gemm g{WMKV + (size_t)512 * D, MEMN, D, D, D}; pg8::StaticOrder S; S.init(512, NB * 256, G, (cu + 96) % G); pg8::EpiStore E{MVT, NB * 256, 0, nullptr, 0}; pg8::gemm_phase(lds, g, S, E); }
    }
    SEAM(9);
    if (IN(10)) {
        for (int it = gw; it < NB * 256 * 4; it += NGW) norm128(MK + (size_t)(it >> 2) * 512 + (it & 3) * 128, args.in[26], 1.f, lane);
        if (IN(9)) xcd_barrier(xbar);
    }
    if (IN(10)) {
        for (int u = cu; u < 256; u += G) {
            const int bhx = (u & 7) * 4 + (u >> 6), b = bhx >> 2, h = bhx & 3, qb = (u >> 3) & 7;
            const size_t r0 = (size_t)b * SEQ + qb * 256;
            attn_unit_dma<128, 2>(lds, MQ + r0 * 512 + h * 128, 512, MK + (size_t)b * 256 * 512 + h * 128, 512, MVT + (size_t)(h * 128) * (NB * 256) + b * 256, NB * 256,
                           OMEM + r0 * 512 + h * 128, 512, 4, 3, args.in[25], 0.08838834764831845f * LOG2E);
        }
    }
    SEAM(10);
    if (IN(11)) {
        pg8::Gemm g{OMEM, WMO, 512, 512, 512}; pg8::StaticOrder S; S.init(T, D, G, cu);
        pg8::EpiResid<2, true, WS_H, WS_SS + (size_t)T * 8> E{out, out, ws};
        pg8::gemm_phase(lds, g, S, E);
    }
    SEAM(11);
    if (IN(12)) {
        pg8::Gemm g{H, WGU, D, D, D}; pg8::StaticOrder S; S.init(T, 2 * FF, G, cu);
        pg8::EpiSwiglu E{ACT, FF, SS3};
        pg8::gemm_phase(lds, g, S, E);
    }
    SEAM(12);
    if (IN(13)) {
        pg8::Gemm g{ACT, WD, FF, FF, FF}; pg8::StaticOrder S; S.init(T, D, G, cu);
        pg8::EpiResid<1, false, 0, 0> E{out, out, ws};
        pg8::gemm_phase(lds, g, S, E);
    }
#undef IN
#undef SEAM
#undef CVT_DEC
}

constexpr int N_PHASES = 14;

extern "C" void kernel_launch(void* const* d_in, const int* in_sizes, int n_in, void* d_out, int out_size, void* d_ws, size_t ws_size, hipStream_t stream) {
    static int grid = 0;
    if (grid == 0) {
        if (n_in != 31 || ws_size < WS_END2) { fprintf(stderr, "kernel_launch: unexpected n_in %d or ws_size %zu (need %zu)\n", n_in, ws_size, (size_t)WS_END2); grid = -1; return; }
        int dev = 0, cus = 0, per_cu = 0;
        (void)hipGetDevice(&dev);
        (void)hipDeviceGetAttribute(&cus, hipDeviceAttributeMultiprocessorCount, dev);
        if (hipFuncSetAttribute((const void*)mega_fwd, hipFuncAttributeMaxDynamicSharedMemorySize, LDS_BYTES) != hipSuccess) { fprintf(stderr, "kernel_launch: hipFuncSetAttribute failed\n"); grid = -1; return; }
        if (hipOccupancyMaxActiveBlocksPerMultiprocessor(&per_cu, (const void*)mega_fwd, 512, LDS_BYTES) != hipSuccess || per_cu < 1) { fprintf(stderr, "kernel_launch: occupancy query says %d\n", per_cu); per_cu = 1; }
        (void)hipGetLastError();
        grid = cus * 1;
        fprintf(stderr, "kernel_launch: grid %d (cus %d, per_cu %d), ws %zu MiB\n", grid, cus, per_cu, ws_size >> 20);
    }
    if (grid < 0) return;
    Args a{};
    for (int i = 0; i < 31; ++i) a.in[i] = (const float*)d_in[i];
    a.out = (float*)d_out; a.ws = (unsigned char*)d_ws;
#if MK_N_LAUNCHES == 1
    (void)hipMemsetAsync((char*)d_ws + WS_BAR, 0, 16384, stream);
    a.ph_lo = 0; a.ph_hi = N_PHASES; a.rmask = RMASK;
    void* kargs[] = {&a};
    hipError_t e = hipLaunchCooperativeKernel((const void*)mega_fwd, dim3(grid), dim3(512), kargs, LDS_BYTES, stream);
    if (e != hipSuccess) fprintf(stderr, "cooperative launch failed: %s (grid %d)\n", hipGetErrorString(e), grid);
#else
#ifndef RUN_PHASES
#define RUN_PHASES 14
#endif
    for (int p = 0; p < RUN_PHASES; ++p) {
        const int pe = (p == 5) ? p + 1 : p;
        const int reps = 1 + ((RMASK >> p) & 1);
        for (int r = 0; r < reps; ++r)
            for (int q = p; q <= pe; ++q) { a.ph_lo = q; a.ph_hi = q + 1; hipLaunchKernelGGL(mega_fwd, dim3(grid), dim3(512), LDS_BYTES, stream, a); }
        p = pe;
    }
#endif
}
```
